# Optimizing an MI355X kernel written in HIP

```python
import math
import jax, jax.numpy as jnp
from jax import lax
import numpy as np

D_MODEL = 1024
BATCH = 1
SEQ = 16384
DEPTH = 2
DEC_BATCH = 16
DEC_SEQ = 4096
PAST_LEN = 128

N_MIXERS = 2
N_A_LAYERS = (DEPTH + 1) // 2
N_B_LAYERS = DEPTH // 2

GDN_HEADS = 8
GDN_DK = 128
GDN_DV = 128
GDN_QK = GDN_HEADS * GDN_DK
GDN_V = GDN_HEADS * GDN_DV
GDN_QKV = 2 * GDN_QK + GDN_V
GDN_IN = GDN_QKV + GDN_V + 4 * GDN_HEADS
GDN_CONV = 5
GDN_CHUNK = 64

ATT_HEADS = 12
ATT_HEAD_DIM = 64
ATT_WIDTH = ATT_HEADS * ATT_HEAD_DIM
ATT_GROUPS = ((128, 1), (512, 4), (2048, 16))
ATT_HEADS_PER_GROUP = ATT_HEADS // len(ATT_GROUPS)
ATT_BLOCK = 64
REL_BUCKETS = 32
REL_MAX_DIST = 1024
NEG_INF = -1e30

D_FF = 2816
FFN_CONV = 3
EPS = 1e-6

kernel_name = "hybrid_gdn_dilated_encoder"


def rmsnorm(x, w):
    xf = x.astype(jnp.float32)
    y = xf * lax.rsqrt(jnp.mean(xf * xf, axis=-1, keepdims=True) + EPS)
    return (y * w.astype(jnp.float32)).astype(x.dtype)


def l2norm(x):
    xf = x.astype(jnp.float32)
    return xf * lax.rsqrt(jnp.sum(xf * xf, axis=-1, keepdims=True) + EPS)


def dwconv_centred(x, w, b=None):
    K = w.shape[0]
    p = K // 2
    T = x.shape[1]
    xp = jnp.pad(x, ((0, 0), (p, p), (0, 0)))
    y = xp[:, 0:T] * w[0]
    for i in range(1, K):
        y = y + xp[:, i:i + T] * w[i]
    if b is not None:
        y = y + b
    return y


def gated_delta_rule_chunked(q, k, v, g, beta):
    B, T, H, DK = q.shape
    DV = v.shape[-1]
    C = GDN_CHUNK
    N = T // C
    f32 = jnp.float32

    def to_chunks(t):
        return t.astype(f32).reshape(B, N, C, H, -1).transpose(0, 3, 1, 2, 4)

    q, k, v = to_chunks(q), to_chunks(k), to_chunks(v)
    g = g.astype(f32).reshape(B, N, C, H).transpose(0, 3, 1, 2)
    beta = beta.astype(f32).reshape(B, N, C, H).transpose(0, 3, 1, 2)
    gc = jnp.cumsum(g, axis=-1)
    incl = np.tril(np.ones((C, C), bool))
    strict = np.tril(np.ones((C, C), bool), -1)
    diff = gc[..., :, None] - gc[..., None, :]
    decay = jnp.where(incl, jnp.exp(jnp.where(incl, diff, 0.0)), 0.0)
    kb = k * beta[..., None]
    lower = jnp.where(strict, jnp.einsum("bhncd,bhnsd->bhncs", kb, k) * decay, 0.0)
    a_mat = lower + jnp.eye(C, dtype=f32)
    rhs = jnp.concatenate([v * beta[..., None], kb * jnp.exp(gc)[..., None]], axis=-1)
    sol = lax.linalg.triangular_solve(a_mat, rhs, left_side=True, lower=True, unit_diagonal=True)
    u, w = sol[..., :DV], sol[..., DV:]
    attn = jnp.where(incl, jnp.einsum("bhncd,bhnsd->bhncs", q, k) * decay, 0.0)
    g_last = gc[..., -1]
    q_dec = q * jnp.exp(gc)[..., None]
    k_dec = k * jnp.exp(g_last[..., None] - gc)[..., None]

    def step(S, inp):
        u_i, w_i, q_i, k_i, a_i, gl_i = inp
        v_new = u_i - jnp.einsum("bhck,bhkv->bhcv", w_i, S)
        o_i = jnp.einsum("bhck,bhkv->bhcv", q_i, S) + jnp.einsum("bhcs,bhsv->bhcv", a_i, v_new)
        S = S * jnp.exp(gl_i)[..., None, None] + jnp.einsum("bhck,bhcv->bhkv", k_i, v_new)
        return S, o_i

    def lead(t):
        return jnp.moveaxis(t, 2, 0)

    xs = (lead(u), lead(w), lead(q_dec), lead(k_dec), lead(attn), lead(g_last))
    _, o = lax.scan(step, jnp.zeros((B, H, DK, DV), f32), xs)
    return o.transpose(1, 0, 3, 2, 4).reshape(B, T, H, DV)


def gdn_mixer(x, w_in, conv_w, a_log, dt_bias, onorm_w, w_out):
    B, T, _ = x.shape
    proj = x @ w_in
    qkv = jax.nn.silu(dwconv_centred(proj[..., :GDN_QKV], conv_w))
    z = proj[..., GDN_QKV:GDN_QKV + GDN_V].reshape(B, T, GDN_HEADS, GDN_DV)
    gates = proj[..., GDN_QKV + GDN_V:].astype(jnp.float32).reshape(B, T, 4, GDN_HEADS)
    q = l2norm(qkv[..., :GDN_QK].reshape(B, T, GDN_HEADS, GDN_DK)) * (GDN_DK ** -0.5)
    k = l2norm(qkv[..., GDN_QK:2 * GDN_QK].reshape(B, T, GDN_HEADS, GDN_DK))
    v = qkv[..., 2 * GDN_QK:].reshape(B, T, GDN_HEADS, GDN_DV)
    a_log = a_log.astype(jnp.float32)
    dt_bias = dt_bias.astype(jnp.float32)
    g_f = -jnp.exp(a_log[0]) * jax.nn.softplus(gates[:, :, 0] + dt_bias[0])
    g_b = -jnp.exp(a_log[1]) * jax.nn.softplus(gates[:, :, 1] + dt_bias[1])
    beta_f = jax.nn.sigmoid(gates[:, :, 2])
    beta_b = jax.nn.sigmoid(gates[:, :, 3])
    o_f = gated_delta_rule_chunked(q, k, v, g_f, beta_f)
    flip = lambda t: t[:, ::-1]
    o_b = flip(gated_delta_rule_chunked(flip(q), flip(k), flip(v), flip(g_b), flip(beta_b)))
    o = (o_f + o_b).astype(x.dtype)
    o = rmsnorm(o, onorm_w) * jax.nn.silu(z)
    return o.reshape(B, T, GDN_V) @ w_out


def t5_bucket(rel):
    nb = REL_BUCKETS // 2
    max_exact = nb // 2
    n = np.abs(rel)
    large = max_exact + (np.log(np.maximum(n, max_exact) / max_exact) / math.log(REL_MAX_DIST / max_exact) * (nb - max_exact)).astype(np.int32)
    large = np.minimum(large, nb - 1)
    return (np.where(rel > 0, nb, 0) + np.where(n < max_exact, n, large)).astype(np.int32)


def dilated_window_attention(q, k, v, bias_tab, window, dilation):
    B, T, Hg, dh = q.shape
    d = dilation
    radius = window // (2 * d)
    L = T // d
    nblk = -(-L // ATT_BLOCK)
    Lp = nblk * ATT_BLOCK

    def to_sub(t):
        t = t.reshape(B, L, d, Hg, dh).transpose(0, 2, 1, 3, 4)
        return jnp.pad(t, ((0, 0), (0, 0), (0, Lp - L), (0, 0), (0, 0)))

    def neighbours(t):
        t = jnp.pad(to_sub(t), ((0, 0), (0, 0), (ATT_BLOCK, ATT_BLOCK), (0, 0), (0, 0)))
        t = t.reshape(B, d, nblk + 2, ATT_BLOCK, Hg, dh)
        return jnp.concatenate([t[:, :, :-2], t[:, :, 1:-1], t[:, :, 2:]], axis=3)

    qs = to_sub(q).reshape(B, d, nblk, ATT_BLOCK, Hg, dh)
    kw, vw = neighbours(k), neighbours(v)
    qi = np.arange(ATT_BLOCK)[:, None]
    ki = np.arange(3 * ATT_BLOCK)[None, :] - ATT_BLOCK
    rel = ki - qi
    in_band = np.abs(rel) <= radius
    s_k = np.arange(nblk)[:, None, None] * ATT_BLOCK + ki[None]
    mask = in_band[None] & (s_k >= 0) & (s_k < L)
    bias = bias_tab.astype(jnp.float32)[t5_bucket(rel * d)]
    bias = bias.transpose(2, 0, 1)
    logits = jnp.einsum("brnqhd,brnkhd->brnhqk", qs, kw).astype(jnp.float32) * (dh ** -0.5) + bias
    logits = jnp.where(mask[None, None, :, None], logits, NEG_INF)
    m = jnp.max(logits, axis=-1, keepdims=True)
    p = jnp.exp(logits - m)
    s = jnp.sum(p, axis=-1)
    o = jnp.einsum("brnhqk,brnkhd->brnqhd", p, vw.astype(jnp.float32)) / s.transpose(0, 1, 2, 4, 3)[..., None]
    lse = (m[..., 0] + jnp.log(s)).transpose(0, 1, 2, 4, 3)
    o = o.reshape(B, d, Lp, Hg, dh)[:, :, :L].transpose(0, 2, 1, 3, 4).reshape(B, T, Hg, dh)
    lse = lse.reshape(B, d, Lp, Hg)[:, :, :L].transpose(0, 2, 1, 3).reshape(B, T, Hg)
    return o, lse


def dilated_mixer(x, w_in, rel_bias, w_out):
    B, T, _ = x.shape
    proj = (x @ w_in).reshape(B, T, 3, ATT_HEADS, ATT_HEAD_DIM)
    q, k, v = proj[:, :, 0], proj[:, :, 1], proj[:, :, 2]
    outs, lses = [], []
    for gi, (window, dil) in enumerate(ATT_GROUPS):
        hs = slice(gi * ATT_HEADS_PER_GROUP, (gi + 1) * ATT_HEADS_PER_GROUP)
        o, lse = dilated_window_attention(q[:, :, hs], k[:, :, hs], v[:, :, hs], rel_bias[:, hs], window, dil)
        outs.append(o)
        lses.append(lse)
    alpha = jax.nn.softmax(jnp.stack(lses, axis=0), axis=0)
    o = jnp.concatenate([outs[gi] * alpha[gi][..., None] for gi in range(len(ATT_GROUPS))], axis=2)
    return o.astype(x.dtype).reshape(B, T, ATT_WIDTH) @ w_out


def conv_ffn(x, w_up, conv_w, conv_b, w_down):
    h = dwconv_centred(x @ w_up, conv_w, conv_b)
    val, gate = h[..., :D_FF], h[..., D_FF:]
    return (jax.nn.silu(gate) * val) @ w_down


def trunk(x, norm_mix, norm_ffn, norm_final, gdn_w_in, gdn_conv, gdn_a_log, gdn_dt_bias, gdn_norm, gdn_w_out,
          att_w_in, att_w_out, rel_bias, ffn_w_up, ffn_conv, ffn_conv_b, ffn_w_down):
    for i in range(DEPTH):
        h = rmsnorm(x, norm_mix[i])
        j = i // N_MIXERS
        if i % N_MIXERS == 0:
            h = gdn_mixer(h, gdn_w_in[j], gdn_conv[j], gdn_a_log[j], gdn_dt_bias[j], gdn_norm[j], gdn_w_out[j])
        else:
            h = dilated_mixer(h, att_w_in[j], rel_bias, att_w_out[j])
        x = x + h
        x = x + conv_ffn(rmsnorm(x, norm_ffn[i]), ffn_w_up[i], ffn_conv[i], ffn_conv_b[i], ffn_w_down[i])
    return rmsnorm(x, norm_final)


def setup_inputs(seed: int = 0) -> dict:
    key = jax.random.key(seed)
    ks = jax.random.split(key, 20)
    f32 = jnp.float32

    def dense(k, shape, fan_in):
        return jax.random.normal(k, shape, f32) * (fan_in ** -0.5)

    def gain(k, shape):
        return 1.0 + 0.02 * jax.random.normal(k, shape, f32)

    x_prompt = jax.random.normal(ks[0], (BATCH, SEQ, D_MODEL), f32)
    x_sample = jax.random.normal(ks[1], (DEC_BATCH, DEC_SEQ, D_MODEL), f32)
    norm_mix = gain(ks[2], (DEPTH, D_MODEL))
    norm_ffn = gain(ks[3], (DEPTH, D_MODEL))
    norm_final = gain(ks[4], (D_MODEL,))
    gdn_w_in = dense(ks[5], (N_A_LAYERS, D_MODEL, GDN_IN), D_MODEL)
    gdn_conv = dense(ks[6], (N_A_LAYERS, GDN_CONV, GDN_QKV), GDN_CONV)
    gdn_a_log = jnp.log(jax.random.uniform(ks[7], (N_A_LAYERS, 2, GDN_HEADS), f32, 1.0, 16.0))
    dt = jnp.exp(jax.random.uniform(ks[8], (N_A_LAYERS, 2, GDN_HEADS), f32, math.log(1e-3), math.log(1e-1)))
    gdn_dt_bias = dt + jnp.log(-jnp.expm1(-dt))
    gdn_norm = gain(ks[9], (N_A_LAYERS, GDN_DV))
    gdn_w_out = dense(ks[10], (N_A_LAYERS, GDN_V, D_MODEL), GDN_V)
    att_w_in = dense(ks[11], (N_B_LAYERS, D_MODEL, 3 * ATT_WIDTH), D_MODEL)
    att_w_out = dense(ks[12], (N_B_LAYERS, ATT_WIDTH, D_MODEL), ATT_WIDTH)
    rel_bias = 0.5 * jax.random.normal(ks[13], (REL_BUCKETS, ATT_HEADS), f32)
    ffn_w_up = dense(ks[14], (DEPTH, D_MODEL, 2 * D_FF), D_MODEL)
    ffn_conv = dense(ks[15], (DEPTH, FFN_CONV, 2 * D_FF), FFN_CONV)
    ffn_conv_b = 0.02 * jax.random.normal(ks[16], (DEPTH, 2 * D_FF), f32)
    ffn_w_down = dense(ks[17], (DEPTH, D_FF, D_MODEL), D_FF)
    return {"x_prompt": x_prompt, "x_sample": x_sample, "norm_mix": norm_mix, "norm_ffn": norm_ffn,
            "norm_final": norm_final, "gdn_w_in": gdn_w_in, "gdn_conv": gdn_conv, "gdn_a_log": gdn_a_log,
            "gdn_dt_bias": gdn_dt_bias, "gdn_norm": gdn_norm, "gdn_w_out": gdn_w_out, "att_w_in": att_w_in,
            "att_w_out": att_w_out, "rel_bias": rel_bias, "ffn_w_up": ffn_w_up, "ffn_conv": ffn_conv,
            "ffn_conv_b": ffn_conv_b, "ffn_w_down": ffn_w_down}


def reference(x_prompt, x_sample, norm_mix, norm_ffn, norm_final, gdn_w_in, gdn_conv, gdn_a_log, gdn_dt_bias,
              gdn_norm, gdn_w_out, att_w_in, att_w_out, rel_bias, ffn_w_up, ffn_conv, ffn_conv_b, ffn_w_down):
    y_prompt = trunk(x_prompt, norm_mix, norm_ffn, norm_final, gdn_w_in, gdn_conv, gdn_a_log, gdn_dt_bias, gdn_norm,
                     gdn_w_out, att_w_in, att_w_out, rel_bias, ffn_w_up, ffn_conv, ffn_conv_b, ffn_w_down)
    y_sample = trunk(x_sample, norm_mix, norm_ffn, norm_final, gdn_w_in, gdn_conv, gdn_a_log, gdn_dt_bias, gdn_norm,
                     gdn_w_out, att_w_in, att_w_out, rel_bias, ffn_w_up, ffn_conv, ffn_conv_b, ffn_w_down)
    return (y_prompt, y_sample)
```

```cpp
#include <hip/hip_runtime.h>
#include <hip/hip_cooperative_groups.h>
#include <cstdio>
namespace cg = cooperative_groups;
namespace pg8 {
#define PG8_LAS __attribute__((address_space(3)))
typedef unsigned short bf16_t;
typedef short bf16x8 __attribute__((ext_vector_type(8)));
typedef float f32x4 __attribute__((ext_vector_type(4)));
typedef unsigned u32x4 __attribute__((ext_vector_type(4)));
constexpr int BM = 256, BK = 64, HALF = 128, HTB = HALF * BK * 2  , STAGE_BYTES = 8 * HTB, NXCD = 8, WGM = 8;

__host__ __device__ __forceinline__ int lds_byte(int r, int c) { const int st = (r >> 4) * 2 + (c >> 5), rr = r & 15, cc = c & 31, ob = rr * 64 + cc * 2; return st * 1024 + (ob ^ (((ob >> 9) & 1) << 5)); }
__host__ __device__ __forceinline__ void stage_rc(int b, int& R, int& C) { const int st = b / 1024, sb = b % 1024, swz = sb ^ (((sb >> 9) & 1) << 5); R = (st >> 1) * 16 + swz / 64; C = (st & 1) * 32 + (swz % 64) / 2; }
__host__ __device__ __forceinline__ int perm32(int rho) { const int n = rho >> 4, i = rho & 15; return 8 * (i >> 2) + 4 * n + (i & 3); }

struct Unit { int pm, pn; };
struct Gemm { const bf16_t* A; const bf16_t* Bt; int M, N, K; };
struct StaticOrder {
    int nM, nN, nwg, G, c;
    __host__ __device__ void init(int M, int N, int G_, int c_) { nM = M / BM; nN = N / BM; nwg = nM * nN; G = G_; c = c_; }
    __host__ __device__ bool next(int i, Unit& u) const {
        const long L = (long)i * G + c; if (L >= nwg) return false;
        int wgid = (int)L; { const int q = nwg / NXCD, r = nwg % NXCD, xcd = wgid % NXCD, off = wgid / NXCD; wgid = (xcd < r ? xcd * (q + 1) : r * (q + 1) + (xcd - r) * q) + off; }
        const int nig = WGM * nN, gid = wgid / nig, fm = gid * WGM, gsz = (nM - fm) < WGM ? (nM - fm) : WGM;
        u.pm = fm + ((wgid % nig) % gsz); u.pn = (wgid % nig) / gsz; return true;
    }
    __device__ __forceinline__ void a_ready(const Unit&) const {}
    __device__ __forceinline__ void done(const Unit&) const {}
};
__device__ __forceinline__ unsigned cvt_pk_bf16(float lo, float hi) { unsigned r; asm volatile("v_cvt_pk_bf16_f32 %0, %1, %2" : "=v"(r) : "v"(lo), "v"(hi)); return r; }
template <class Epi, class Sched>
__device__ __forceinline__ void gemm_phase(PG8_LAS unsigned char* lds, const Gemm g, const Sched& S, const Epi& E, const int tid_in) {
    const int tid = tid_in, wid = __builtin_amdgcn_readfirstlane(tid >> 6), lane = tid & 63, wr = wid >> 2, wc = wid & 3, fr = lane & 15, fq = lane >> 4;
    const int K = g.K, nt = K / BK;
    unsigned voffA[2], voffB[2];
#pragma unroll
    for (int i = 0; i < 2; ++i) { int R, C; stage_rc(tid * 16 + i * 8192, R, C); const int Rb = Epi::PERM ? ((R & ~31) + perm32(R & 31)) : R;
        voffA[i] = (unsigned)(R * K + C) * 2u; voffB[i] = (unsigned)(Rb * K + C) * 2u; }
    const size_t kstep = (size_t)(BK * 2);
    const size_t hstep = (size_t)HALF * K * 2;
    const size_t tstep = 2 * hstep;
    const unsigned ldsw = (unsigned)wid * 1024u;
    const int aoff = lds_byte(wr * 64 + fr, fq * 8), boff = lds_byte(wc * 32 + fr, fq * 8);
#define PG8_SA(b, h) (((b) * 2 + (h)) * HTB)
#define PG8_SB(b, h) ((4 + (b) * 2 + (h)) * HTB)
#define PG8_STAGE(bufoff, gbase, voff) do { _Pragma("unroll") for (int _i = 0; _i < 2; ++_i) \
        __builtin_amdgcn_global_load_lds((const unsigned*)((const char*)(gbase) + (voff)[_i]), (PG8_LAS unsigned*)(lds + (bufoff) + ldsw + _i * 8192), 16, 0, 0); } while (0)
#define PG8_LDA(dst, b, h) do { _Pragma("unroll") for (int m = 0; m < 4; ++m) _Pragma("unroll") for (int k = 0; k < 2; ++k) dst[m][k] = *(const PG8_LAS bf16x8*)(lds + PG8_SA(b, h) + aoff + m * 2048 + k * 1024); } while (0)
#define PG8_LDB(dst, b, h) do { _Pragma("unroll") for (int n = 0; n < 2; ++n) _Pragma("unroll") for (int k = 0; k < 2; ++k) dst[n][k] = *(const PG8_LAS bf16x8*)(lds + PG8_SB(b, h) + boff + n * 2048 + k * 1024); } while (0)
#define PG8_MMA(ai, bj, At, Bt) do { __builtin_amdgcn_s_setprio(1); _Pragma("unroll") for (int m = 0; m < 4; ++m) _Pragma("unroll") for (int n = 0; n < 2; ++n) _Pragma("unroll") for (int k = 0; k < 2; ++k) \
        acc[ai][bj][m][n] = __builtin_amdgcn_mfma_f32_16x16x32_bf16(Bt[n][k], At[m][k], acc[ai][bj][m][n], 0, 0, 0); __builtin_amdgcn_s_setprio(0); } while (0)
#define PG8_WAIT_V(n) asm volatile("s_waitcnt vmcnt(" #n ")" ::: "memory")
#define PG8_WAIT_L(n) asm volatile("s_waitcnt lgkmcnt(" #n ")" ::: "memory")
#define PG8_BAR __builtin_amdgcn_s_barrier()
#define PG8_SCHED __builtin_amdgcn_sched_barrier(0)
    Unit cur, nxt; int ui = 0;
    if (!S.next(0, cur)) return;
    f32x4 acc[2][2][4][2];
#pragma unroll
    for (int a = 0; a < 2; ++a)
#pragma unroll
        for (int b = 0; b < 2; ++b)
#pragma unroll
            for (int m = 0; m < 4; ++m)
#pragma unroll
                for (int n = 0; n < 2; ++n) acc[a][b][m][n] = (f32x4){0.f, 0.f, 0.f, 0.f};
    bf16x8 At[4][2], B0[2][2], B1[2][2];
    const char* cA = (const char*)g.A + (size_t)cur.pm * tstep; const char* cB = (const char*)g.Bt + (size_t)cur.pn * tstep;
    S.a_ready(cur);
    PG8_STAGE(PG8_SB(0, 0), cB, voffB); PG8_STAGE(PG8_SA(0, 0), cA, voffA); PG8_STAGE(PG8_SB(0, 1), cB + hstep, voffB); PG8_STAGE(PG8_SA(0, 1), cA + hstep, voffA);
    if (wr == 1) PG8_BAR;
    PG8_WAIT_V(4); PG8_BAR;
    PG8_STAGE(PG8_SB(1, 0), cB + kstep, voffB); PG8_STAGE(PG8_SA(1, 0), cA + kstep, voffA); PG8_STAGE(PG8_SB(1, 1), cB + hstep + kstep, voffB);
    PG8_WAIT_V(6); PG8_BAR;
    for (;;) {
        const bool has_next = S.next(ui + 1, nxt);
        const char* nA = has_next ? (const char*)g.A + (size_t)nxt.pm * tstep : cA; const char* nB = has_next ? (const char*)g.Bt + (size_t)nxt.pn * tstep : cB;
        for (int t = 0; t < nt; t += 2) {
            const bool last = (t == nt - 2);
            const char* a1 = cA + (size_t)(t + 1) * kstep;
            const char* a2 = last ? nA : cA + (size_t)(t + 2) * kstep; const char* b2 = last ? nB : cB + (size_t)(t + 2) * kstep;
            const char* a3 = a2 + kstep; const char* b3 = b2 + kstep;
            if (last && has_next) S.a_ready(nxt);
            PG8_LDB(B0, 0, 0); PG8_SCHED; PG8_LDA(At, 0, 0); PG8_STAGE(PG8_SA(1, 1), a1 + hstep, voffA);
            PG8_WAIT_L(8); PG8_BAR; PG8_WAIT_L(0); PG8_MMA(0, 0, At, B0); PG8_BAR; PG8_SCHED;
            PG8_LDB(B1, 0, 1); PG8_STAGE(PG8_SB(0, 0), b2, voffB);
            PG8_BAR; PG8_WAIT_L(0); PG8_MMA(0, 1, At, B1); PG8_BAR;
            PG8_LDA(At, 0, 1); PG8_STAGE(PG8_SA(0, 0), a2, voffA);
            PG8_BAR; PG8_WAIT_L(0); PG8_MMA(1, 0, At, B0); PG8_BAR; PG8_SCHED;
            PG8_STAGE(PG8_SB(0, 1), b2 + hstep, voffB);
            PG8_WAIT_V(6); PG8_BAR; PG8_MMA(1, 1, At, B1); PG8_BAR;
            PG8_LDB(B0, 1, 0); PG8_SCHED; PG8_LDA(At, 1, 0); PG8_STAGE(PG8_SA(0, 1), a2 + hstep, voffA);
            PG8_WAIT_L(8); PG8_BAR; PG8_WAIT_L(0); PG8_MMA(0, 0, At, B0); PG8_BAR; PG8_SCHED;
            PG8_LDB(B1, 1, 1); PG8_STAGE(PG8_SB(1, 0), b3, voffB);
            PG8_BAR; PG8_WAIT_L(0); PG8_MMA(0, 1, At, B1); PG8_BAR;
            PG8_LDA(At, 1, 1); PG8_STAGE(PG8_SA(1, 0), a3, voffA);
            PG8_BAR; PG8_WAIT_L(0); PG8_MMA(1, 0, At, B0); PG8_BAR; PG8_SCHED;
            PG8_STAGE(PG8_SB(1, 1), b3 + hstep, voffB);
            PG8_WAIT_V(6); PG8_BAR; PG8_MMA(1, 1, At, B1); PG8_BAR;
        }
        if constexpr (!Epi::AFTER_DRAIN) { E(acc, cur, wr, wc, fr, fq); S.done(cur); }
        if (!has_next) break;
#pragma unroll
        for (int a = 0; a < 2; ++a)
#pragma unroll
            for (int b = 0; b < 2; ++b)
#pragma unroll
                for (int m = 0; m < 4; ++m)
#pragma unroll
                    for (int n = 0; n < 2; ++n) acc[a][b][m][n] = (f32x4){0.f, 0.f, 0.f, 0.f};
        cur = nxt; cA = nA; cB = nB; ++ui;
    }
    PG8_WAIT_V(0);
    if (wr == 0) PG8_BAR;
    PG8_BAR;
    if constexpr (Epi::AFTER_DRAIN) { E.fused(acc, cur, wr, wc, fr, fq, lds, wid, lane); S.done(cur); }
#undef PG8_SA
#undef PG8_SB
#undef PG8_STAGE
#undef PG8_LDA
#undef PG8_LDB
#undef PG8_MMA
#undef PG8_WAIT_V
#undef PG8_WAIT_L
#undef PG8_BAR
#undef PG8_SCHED
}
}

using pg8::bf16_t; using pg8::bf16x8; using pg8::f32x4; using pg8::u32x4; using pg8::Unit; using pg8::cvt_pk_bf16;
typedef unsigned u32x2 __attribute__((ext_vector_type(2)));
typedef float f32x16 __attribute__((ext_vector_type(16)));
#define LAS __attribute__((address_space(3)))
typedef LAS unsigned char* ldsp;

constexpr int MTOK = 81920, TPROMPT = 16384, TSAMP = 4096, DMODEL = 1024;
constexpr int LDS_BYTES = 131072;
constexpr int NTHR = 512;

constexpr size_t WS_W  = 0;
constexpr size_t WS_R1 = 67108864;
constexpr size_t WS_R2 = WS_R1 + 167772160;
constexpr size_t WS_R3 = WS_R2 + 167772160;
constexpr size_t WS_R4 = WS_R3 + 503316480;
constexpr size_t WS_END = WS_R4 + 10485760;
constexpr size_t W_GDN_IN = 0, W_GDN_OUT = W_GDN_IN + (size_t)4352 * 1024, W_ATT_IN = W_GDN_OUT + (size_t)1024 * 1024, W_ATT_OUT = W_ATT_IN + (size_t)2304 * 1024,
                 W_FFN_UP = W_ATT_OUT + (size_t)1024 * 768, W_FFN_DOWN = W_FFN_UP + (size_t)2 * 5632 * 1024, W_TOTAL = W_FFN_DOWN + (size_t)2 * 1024 * 2816;
static_assert(W_TOTAL * 2 <= WS_R1, "weights overflow");

struct Params { const float* in[18]; float* out; unsigned char* ws; };

__device__ __forceinline__ unsigned short f2bf(float f) { unsigned u = __float_as_uint(f); u += 0x7FFFu + ((u >> 16) & 1u); return (unsigned short)(u >> 16); }
__device__ __forceinline__ float bf_lo(unsigned u) { return __uint_as_float(u << 16); }
__device__ __forceinline__ float bf_hi(unsigned u) { return __uint_as_float(u & 0xffff0000u); }
__device__ __forceinline__ float bf2f(unsigned short b) { return __uint_as_float(((unsigned)b) << 16); }
__device__ __forceinline__ float silu_f(float v) { return v / (1.f + __expf(-v)); }
__device__ __forceinline__ bf16x8 as_bf16x8(u32x4 v) { union { u32x4 u; bf16x8 b; } c; c.u = v; return c.b; }
__device__ __forceinline__ bf16x8 pack8(f32x4 a, f32x4 b) { u32x4 v; v.x = cvt_pk_bf16(a[0], a[1]); v.y = cvt_pk_bf16(a[2], a[3]); v.z = cvt_pk_bf16(b[0], b[1]); v.w = cvt_pk_bf16(b[2], b[3]); return as_bf16x8(v); }
__device__ __forceinline__ bf16x8 lds_read2(ldsp p) { const u32x2 lo = *(LAS const u32x2*)p, hi = *(LAS const u32x2*)(p + 32); u32x4 v; v.x = lo.x; v.y = lo.y; v.z = hi.x; v.w = hi.y; return as_bf16x8(v); }
__device__ __forceinline__ void seq_bounds(int t, int& s0, int& s1) { if (t < TPROMPT) { s0 = 0; s1 = TPROMPT; } else { s0 = t & ~(TSAMP - 1); s1 = s0 + TSAMP; } }
#define FENCE() do { asm volatile("" ::: "memory"); __builtin_amdgcn_sched_barrier(0); } while (0)
#define MFMA16(a, b, c) __builtin_amdgcn_mfma_f32_16x16x32_bf16((a), (b), (c), 0, 0, 0)
#define MFMA32(a, b, c) __builtin_amdgcn_mfma_f32_32x32x16_bf16((a), (b), (c), 0, 0, 0)

__device__ __forceinline__ void wt_convert(const int tid, ldsp L, const float* __restrict__ w, bf16_t* __restrict__ bt, int K, int N, int Npad) {
    LAS float* tile = (LAS float*)L;
    const int nkt = K / 64, nnt = Npad / 64, ntile = nkt * nnt;
    for (int t = blockIdx.x; t < ntile; t += gridDim.x) {
        const int kt = t % nkt, nt_ = t / nkt, k0 = kt * 64, n0 = nt_ * 64;
#pragma unroll
        for (int i = 0; i < 8; ++i) { const int idx = tid + NTHR * i, kk = idx >> 6, nn = idx & 63; tile[kk * 65 + nn] = (n0 + nn < N) ? w[(size_t)(k0 + kk) * N + n0 + nn] : 0.f; }
        __syncthreads();
#pragma unroll
        for (int i = 0; i < 8; ++i) { const int idx = tid + NTHR * i, nn = idx >> 6, kk = idx & 63; bt[(size_t)(n0 + nn) * K + k0 + kk] = f2bf(tile[kk * 65 + nn]); }
        __syncthreads();
    }
}

template <bool FINAL>
__device__ __forceinline__ void rmsnorm_phase(const int tid, const float* x0, const float* x1, int split, const float* __restrict__ w, bf16_t* dst, float* fdst) {
    const int lane = tid & 63, wid = tid >> 6;
    f32x4 wv[4];
#pragma unroll
    for (int j = 0; j < 4; ++j) wv[j] = *(const f32x4*)(w + lane * 4 + 256 * j);
    for (int row = blockIdx.x * 8 + wid; row < MTOK; row += gridDim.x * 8) {
        const float* xr = row < split ? x0 + (size_t)row * DMODEL : x1 + (size_t)(row - split) * DMODEL;
        f32x4 v[4]; float ss = 0.f;
#pragma unroll
        for (int j = 0; j < 4; ++j) { v[j] = *(const f32x4*)(xr + lane * 4 + 256 * j); ss += v[j][0] * v[j][0] + v[j][1] * v[j][1] + v[j][2] * v[j][2] + v[j][3] * v[j][3]; }
#pragma unroll
        for (int o = 32; o >= 1; o >>= 1) ss += __shfl_xor(ss, o);
        const float r = rsqrtf(ss * (1.f / 1024.f) + 1e-6f);
#pragma unroll
        for (int j = 0; j < 4; ++j) {
            const f32x4 y = v[j] * r * wv[j];
            if (FINAL) *(f32x4*)(fdst + (size_t)row * DMODEL + lane * 4 + 256 * j) = y;
            else { u32x2 o2; o2.x = cvt_pk_bf16(y[0], y[1]); o2.y = cvt_pk_bf16(y[2], y[3]); *(u32x2*)(dst + (size_t)row * DMODEL + lane * 4 + 256 * j) = o2; }
        }
    }
}

struct EpiResid {
    static constexpr bool PERM = false, AFTER_DRAIN = false;
    float* out; const float* r0; const float* r1; int split;
    __device__ __forceinline__ void operator()(const f32x4 (&acc)[2][2][4][2], const Unit& u, int wr, int wc, int fr, int fq) const {
        const int row0 = u.pm * 256 + wr * 64 + fr, col0 = u.pn * 256 + wc * 32 + 4 * fq;
#pragma unroll
        for (int ai = 0; ai < 2; ++ai)
#pragma unroll
            for (int m = 0; m < 4; ++m) { const int row = row0 + ai * 128 + m * 16;
                const float* rp = (row < split ? r0 + (size_t)row * DMODEL : r1 + (size_t)(row - split) * DMODEL) + col0; float* op = out + (size_t)row * DMODEL + col0;
#pragma unroll
                for (int bj = 0; bj < 2; ++bj)
#pragma unroll
                    for (int n = 0; n < 2; ++n) { const f32x4 rv = *(const f32x4*)(rp + bj * 128 + n * 16); *(f32x4*)(op + bj * 128 + n * 16) = rv + acc[ai][bj][m][n]; }
                asm volatile("" ::: "memory"); }
    }
};
template <class Epi>
__device__ __forceinline__ void run_gemm(const int tid, ldsp L, const bf16_t* A, const bf16_t* Bt, int M, int N, int K, const Epi& E) {
    pg8::Gemm g; g.A = A; g.Bt = Bt; g.M = M; g.N = N; g.K = K;
    pg8::StaticOrder S; S.init(M, N, (int)gridDim.x, (int)blockIdx.x);
#ifndef NO_GEMM
    pg8::gemm_phase<Epi, pg8::StaticOrder>(L, g, S, E, tid);
#endif
}

constexpr int G_QH = 0, G_KH = 17408  , G_KT = 34816, G_VT = 53248, G_TB = 71680, G_TW = 80896, G_AT = 90112, G_LM = 99328, G_SC = 116736, G_CW = 118016, G_Y = 125696;
static_assert(G_Y + 32 * 36 * 4 <= LDS_BYTES, "gdn lds");

__device__ __forceinline__ void gdn_item(const int tid0, ldsp L, const Params& p, int gi, const bf16_t* __restrict__ qkv, const float* __restrict__ gates, bf16_t* o_f, bf16_t* o_b) {
    int head, dir, tbase, nsteps;
    if (gi < 16) { head = gi & 7; dir = gi >> 3; tbase = 0; nsteps = TPROMPT / 64; }
    else { const int j = gi - 16; head = j & 7; dir = (j >> 3) & 1; tbase = TPROMPT + (j >> 4) * TSAMP; nsteps = TSAMP / 64; }
    const int s0 = tbase, s1 = tbase + nsteps * 64;
    bf16_t* obuf = dir ? o_b : o_f;
    LAS float* CW = (LAS float*)(L + G_CW);
    const float* convw = p.in[6];
    for (int e = tid0; e < 5 * 384; e += NTHR) { const int i = e / 384, cc = e % 384, tensor = cc >> 7, c = cc & 127; CW[e] = convw[i * 3072 + tensor * 1024 + head * 128 + c]; }
    const float Aexp = expf(p.in[7][dir * 8 + head]), dtb = p.in[8][dir * 8 + head];
    LAS float* SCgc = (LAS float*)(L + G_SC), *SCbeta = SCgc + 64, *SCegc = SCgc + 128, *SCdec = SCgc + 192, *SCegl = SCgc + 256;
    LAS float* LM = (LAS float*)(L + G_LM); LAS float* TM = (LAS float*)(L + G_KH); LAS float* YS = (LAS float*)(L + G_Y);
    f32x4 S[8];
#pragma unroll
    for (int i = 0; i < 8; ++i) S[i] = (f32x4){0.f, 0.f, 0.f, 0.f};
    __syncthreads();

    for (int step = 0; step < nsteps; ++step) {
        int tid; asm volatile("v_mov_b32 %0, %1" : "=v"(tid) : "v"(tid0));
        const int wid = __builtin_amdgcn_readfirstlane(tid >> 6), lane = tid & 63, l15 = lane & 15, q4 = lane >> 4;
        const int chunk = dir ? nsteps - 1 - step : step, t0 = tbase + 64 * chunk;
        if (tid < 384) {
            const int cgp = tid % 48, rr = tid / 48, tensor = cgp >> 4, c8 = (cgp & 15) * 8, col = tensor * 1024 + head * 128 + c8;
#pragma unroll
            for (int hf = 0; hf < 2; ++hf) {
                u32x4 xr[8];
#pragma unroll
                for (int i = 0; i < 8; ++i) { const int t = t0 + 8 * rr + 4 * hf - 2 + i; xr[i] = (t >= s0 && t < s1) ? *(const u32x4*)(qkv + (size_t)t * 3072 + col) : (u32x4){0u, 0u, 0u, 0u}; }
                float o[4][8];
#pragma unroll
                for (int r = 0; r < 4; ++r)
#pragma unroll
                    for (int c = 0; c < 8; ++c) o[r][c] = 0.f;
#pragma unroll
                for (int i = 0; i < 5; ++i) {
                    const f32x4 wa = *(LAS const f32x4*)(CW + i * 384 + tensor * 128 + c8), wb = *(LAS const f32x4*)(CW + i * 384 + tensor * 128 + c8 + 4);
#pragma unroll
                    for (int r = 0; r < 4; ++r) { const u32x4 x = xr[r + i];
                        o[r][0] += wa[0] * bf_lo(x.x); o[r][1] += wa[1] * bf_hi(x.x); o[r][2] += wa[2] * bf_lo(x.y); o[r][3] += wa[3] * bf_hi(x.y);
                        o[r][4] += wb[0] * bf_lo(x.z); o[r][5] += wb[1] * bf_hi(x.z); o[r][6] += wb[2] * bf_lo(x.w); o[r][7] += wb[3] * bf_hi(x.w); }
                }
#pragma unroll
                for (int r = 0; r < 4; ++r) {
                    float ss = 0.f;
#pragma unroll
                    for (int c = 0; c < 8; ++c) { o[r][c] = silu_f(o[r][c]); ss += o[r][c] * o[r][c]; }
                    ss += __shfl_xor(ss, 1); ss += __shfl_xor(ss, 2); ss += __shfl_xor(ss, 4); ss += __shfl_xor(ss, 8);
                    const float sc = tensor == 2 ? 1.f : rsqrtf(ss + 1e-6f) * (tensor == 0 ? 0.08838834764831845f : 1.f);
#pragma unroll
                    for (int c = 0; c < 8; ++c) o[r][c] *= sc;
                }
                if (tensor < 2) {
                    ldsp base = L + (tensor == 0 ? G_QH : G_KH) + (8 * rr + 4 * hf) * 272 + c8 * 2;
#pragma unroll
                    for (int r = 0; r < 4; ++r) { u32x4 v; v.x = cvt_pk_bf16(o[r][0], o[r][1]); v.y = cvt_pk_bf16(o[r][2], o[r][3]); v.z = cvt_pk_bf16(o[r][4], o[r][5]); v.w = cvt_pk_bf16(o[r][6], o[r][7]); *(LAS u32x4*)(base + r * 272) = v; }
                }
                if (tensor >= 1) {
                    ldsp base = L + (tensor == 1 ? G_KT : G_VT) + c8 * 144 + rr * 16 + hf * 8;
#pragma unroll
                    for (int c = 0; c < 8; ++c) { u32x2 v; v.x = cvt_pk_bf16(o[0][c], o[1][c]); v.y = cvt_pk_bf16(o[2][c], o[3][c]); *(LAS u32x2*)(base + c * 144) = v; }
                }
                FENCE();
            }
        } else if (wid == 6) {
            const int t = t0 + lane;
            const float a = gates[(size_t)t * 32 + dir * 8 + head], bb = gates[(size_t)t * 32 + (2 + dir) * 8 + head];
            const float x = a + dtb, sp = fmaxf(x, 0.f) + log1pf(expf(-fabsf(x))), g = -Aexp * sp, beta = 1.f / (1.f + expf(-bb));
            float pre = g;
#pragma unroll
            for (int o = 1; o < 64; o <<= 1) { const float y = __shfl_up(pre, o); if (lane >= o) pre += y; }
            const float tot = __shfl(pre, 63), gc = dir ? (tot - pre + g) : pre;
            SCgc[lane] = gc; SCbeta[lane] = beta; SCegc[lane] = expf(gc); SCdec[lane] = expf(tot - gc); if (lane == 0) SCegl[0] = expf(tot);
        }
        __syncthreads();
        {
            const int mat = wid >> 2, rt = wid & 3;
            ldsp ab = L + (mat ? G_QH : G_KH) + (16 * rt + l15) * 272 + q4 * 16;
            bf16x8 af[4];
#pragma unroll
            for (int kk = 0; kk < 4; ++kk) af[kk] = *(LAS const bf16x8*)(ab + kk * 64);
#pragma unroll
            for (int ct = 0; ct < 4; ++ct) {
                ldsp bb = L + G_KH + (16 * ct + l15) * 272 + q4 * 16;
                f32x4 acc = (f32x4){0.f, 0.f, 0.f, 0.f};
#pragma unroll
                for (int kk = 0; kk < 4; ++kk) acc = MFMA16(af[kk], *(LAS const bf16x8*)(bb + kk * 64), acc);
                const int s = 16 * ct + l15; const float gs = SCgc[s];
#pragma unroll
                for (int j = 0; j < 4; ++j) {
                    const int c = 16 * rt + 4 * q4 + j; const float e = __expf(SCgc[c] - gs);
                    if (mat == 0) { const bool mk = dir ? (s > c) : (s < c); const float val = mk ? acc[j] * SCbeta[c] * e : 0.f; const int fc = dir ? 63 - c : c, fs = dir ? 63 - s : s; LM[fc * 68 + fs] = val; }
                    else { const bool mk = dir ? (s >= c) : (s <= c); const float val = mk ? acc[j] * e : 0.f; *(LAS unsigned short*)(L + G_AT + c * 144 + s * 2) = f2bf(val); }
                }
            }
        }
        __syncthreads();
        if (tid < 64) {
            const int b = tid >> 4, j = tid & 15; float x[16];
#pragma unroll
            for (int i = 0; i < 16; ++i) { float a = (i == j) ? 1.f : 0.f;
#pragma unroll
                for (int s = 0; s < i; ++s) a -= LM[(16 * b + i) * 68 + 16 * b + s] * x[s];
                x[i] = a; TM[(16 * b + i) * 68 + 16 * b + j] = a; if ((i & 3) == 3) FENCE(); }
        } else {
            for (int e = tid - 64; e < 1536; e += NTHR - 64) { const int blk = e >> 8, w = e & 255, i = w >> 4, j = w & 15;
                const int bi = blk < 3 ? 0 : (blk < 5 ? 1 : 2), bj = blk < 3 ? blk + 1 : (blk < 5 ? blk - 1 : 3);
                TM[(16 * bi + i) * 68 + 16 * bj + j] = 0.f; }
        }
        __syncthreads();
        if (tid < 128) {
            const int r0 = 32 * (tid >> 6), i = (tid & 63) >> 2, j4 = (tid & 3) * 4; f32x4 y = (f32x4){0.f, 0.f, 0.f, 0.f};
#pragma unroll
            for (int k = 0; k < 16; k += 4) { const f32x4 a = *(LAS const f32x4*)(LM + (r0 + 16 + i) * 68 + r0 + k);
#pragma unroll
                for (int kk = 0; kk < 4; ++kk) y += a[kk] * *(LAS const f32x4*)(TM + (r0 + k + kk) * 68 + r0 + j4); }
            *(LAS f32x4*)(YS + ((tid >> 6) * 16 + i) * 36 + j4) = y;
        }
        __syncthreads();
        if (tid < 128) {
            const int r0 = 32 * (tid >> 6), i = (tid & 63) >> 2, j4 = (tid & 3) * 4; f32x4 y = (f32x4){0.f, 0.f, 0.f, 0.f};
#pragma unroll
            for (int k = 0; k < 16; k += 4) { const f32x4 a = *(LAS const f32x4*)(TM + (r0 + 16 + i) * 68 + r0 + 16 + k);
#pragma unroll
                for (int kk = 0; kk < 4; ++kk) y -= a[kk] * *(LAS const f32x4*)(YS + ((tid >> 6) * 16 + k + kk) * 36 + j4); }
            *(LAS f32x4*)(TM + (r0 + 16 + i) * 68 + r0 + j4) = y;
        }
        __syncthreads();
        if (tid < 256) {
            const int i = tid >> 3, j4 = (tid & 7) * 4; f32x4 y = (f32x4){0.f, 0.f, 0.f, 0.f};
#pragma unroll
            for (int k = 0; k < 32; k += 4) { const f32x4 a = *(LAS const f32x4*)(LM + (32 + i) * 68 + k);
#pragma unroll
                for (int kk = 0; kk < 4; ++kk) y += a[kk] * *(LAS const f32x4*)(TM + (k + kk) * 68 + j4); }
            *(LAS f32x4*)(YS + i * 36 + j4) = y;
        }
        __syncthreads();
        if (tid < 256) {
            const int i = tid >> 3, j4 = (tid & 7) * 4; f32x4 y = (f32x4){0.f, 0.f, 0.f, 0.f};
#pragma unroll
            for (int k = 0; k < 32; k += 4) { const f32x4 a = *(LAS const f32x4*)(TM + (32 + i) * 68 + 32 + k);
#pragma unroll
                for (int kk = 0; kk < 4; ++kk) y -= a[kk] * *(LAS const f32x4*)(YS + (k + kk) * 36 + j4); }
            *(LAS f32x4*)(TM + (32 + i) * 68 + j4) = y;
        }
        __syncthreads();
        {
            const int c = tid >> 3, s8 = (tid & 7) * 8, fc = dir ? 63 - c : c; float tb[8], tw[8];
#pragma unroll
            for (int e = 0; e < 8; ++e) { const int s = s8 + e, fs = dir ? 63 - s : s; const float tv = TM[fc * 68 + fs]; tb[e] = tv * SCbeta[s]; tw[e] = tb[e] * SCegc[s]; }
            u32x4 v; v.x = cvt_pk_bf16(tb[0], tb[1]); v.y = cvt_pk_bf16(tb[2], tb[3]); v.z = cvt_pk_bf16(tb[4], tb[5]); v.w = cvt_pk_bf16(tb[6], tb[7]); *(LAS u32x4*)(L + G_TB + c * 144 + s8 * 2) = v;
            v.x = cvt_pk_bf16(tw[0], tw[1]); v.y = cvt_pk_bf16(tw[2], tw[3]); v.z = cvt_pk_bf16(tw[4], tw[5]); v.w = cvt_pk_bf16(tw[6], tw[7]); *(LAS u32x4*)(L + G_TW + c * 144 + s8 * 2) = v;
        }
        __syncthreads();
        {
            ldsp ab = L + G_KT + (16 * wid + l15) * 144 + q4 * 16;
            const bf16x8 a0 = *(LAS const bf16x8*)ab, a1 = *(LAS const bf16x8*)(ab + 64);
#pragma unroll
            for (int ct = 0; ct < 4; ++ct) {
                ldsp bb = L + G_TW + (16 * ct + l15) * 144 + q4 * 16;
                f32x4 acc = (f32x4){0.f, 0.f, 0.f, 0.f};
                acc = MFMA16(a0, *(LAS const bf16x8*)bb, acc); acc = MFMA16(a1, *(LAS const bf16x8*)(bb + 64), acc);
                u32x2 v; v.x = cvt_pk_bf16(-acc[0], -acc[1]); v.y = cvt_pk_bf16(-acc[2], -acc[3]);
                *(LAS u32x2*)(L + G_KH + (16 * ct + l15) * 272 + (16 * wid + 4 * q4) * 2) = v;
            }
        }
        __syncthreads();
        {
            const int dv0 = 16 * wid;
            f32x4 vn[4], R[4];
#pragma unroll
            for (int ct = 0; ct < 4; ++ct) { vn[ct] = (f32x4){0.f, 0.f, 0.f, 0.f}; R[ct] = (f32x4){0.f, 0.f, 0.f, 0.f}; }
#pragma unroll
            for (int kk = 0; kk < 2; ++kk) { const bf16x8 bv = *(LAS const bf16x8*)(L + G_VT + (dv0 + l15) * 144 + kk * 64 + q4 * 16);
#pragma unroll
                for (int ct = 0; ct < 4; ++ct) vn[ct] = MFMA16(*(LAS const bf16x8*)(L + G_TB + (16 * ct + l15) * 144 + kk * 64 + q4 * 16), bv, vn[ct]); }
            FENCE();
#pragma unroll
            for (int kk = 0; kk < 4; ++kk) {
                const bf16x8 sb = pack8(S[2 * kk], S[2 * kk + 1]);
#pragma unroll
                for (int ct = 0; ct < 4; ++ct) { const int off = (16 * ct + l15) * 272 + (32 * kk + 4 * q4) * 2;
                    vn[ct] = MFMA16(lds_read2(L + G_KH + off), sb, vn[ct]); R[ct] = MFMA16(lds_read2(L + G_QH + off), sb, R[ct]); }
                FENCE();
            }
#pragma unroll
            for (int ct = 0; ct < 4; ++ct) R[ct] *= *(LAS const f32x4*)(SCegc + 16 * ct + 4 * q4);
            bf16x8 Vb[2], Vd[2];
#pragma unroll
            for (int kk = 0; kk < 2; ++kk) { Vb[kk] = pack8(vn[2 * kk], vn[2 * kk + 1]);
                Vd[kk] = pack8(vn[2 * kk] * *(LAS const f32x4*)(SCdec + 32 * kk + 4 * q4), vn[2 * kk + 1] * *(LAS const f32x4*)(SCdec + 32 * kk + 16 + 4 * q4)); }
            FENCE();
#pragma unroll
            for (int kk = 0; kk < 2; ++kk)
#pragma unroll
                for (int ct = 0; ct < 4; ++ct) R[ct] = MFMA16(lds_read2(L + G_AT + (16 * ct + l15) * 144 + (32 * kk + 4 * q4) * 2), Vb[kk], R[ct]);
#pragma unroll
            for (int ct = 0; ct < 4; ++ct)
#pragma unroll
                for (int j = 0; j < 4; ++j) obuf[(size_t)(t0 + 16 * ct + 4 * q4 + j) * 1024 + head * 128 + dv0 + l15] = f2bf(R[ct][j]);
            FENCE();
            const float egl = SCegl[0];
#pragma unroll
            for (int dkt = 0; dkt < 8; ++dkt) { S[dkt] *= egl;
#pragma unroll
                for (int kk = 0; kk < 2; ++kk) S[dkt] = MFMA16(lds_read2(L + G_KT + (16 * dkt + l15) * 144 + (32 * kk + 4 * q4) * 2), Vd[kk], S[dkt]);
                if (dkt & 1) FENCE(); }
        }
        __syncthreads();
    }
}
__device__ __forceinline__ void gdn_scan_phase(const int tid, ldsp L, const Params& p, const bf16_t* qkv, const float* gates, bf16_t* o_f, bf16_t* o_b) {
    const int b = blockIdx.x, G = gridDim.x;
    for (int k = 0; k < 2; ++k) {
        int gi;
        if (G == 256) { if (k == 0) gi = b; else { if (b < 16 || b >= 32) break; gi = 256 + (b - 16); } }
        else { gi = b + k * G; if (gi >= 272) break; }
        gdn_item(tid, L, p, gi, qkv, gates, o_f, o_b);
    }
}

__device__ __forceinline__ void gdn_combine_phase(const int tid, const Params& p, const bf16_t* o_f, const bf16_t* o_b, const bf16_t* z, bf16_t* dst) {
    const int lane = tid & 63, wid = tid >> 6, d8 = (lane & 15) * 8;
    const float* nw = p.in[9];
    const f32x4 w0 = *(const f32x4*)(nw + d8), w1 = *(const f32x4*)(nw + d8 + 4);
    for (int it = blockIdx.x * 8 + wid; it < MTOK * 2; it += gridDim.x * 8) {
        const size_t off = (size_t)(it >> 1) * 1024 + (it & 1) * 512 + lane * 8;
        const u32x4 a = *(const u32x4*)(o_f + off), b = *(const u32x4*)(o_b + off), zz = *(const u32x4*)(z + off);
        float o[8] = {bf_lo(a.x) + bf_lo(b.x), bf_hi(a.x) + bf_hi(b.x), bf_lo(a.y) + bf_lo(b.y), bf_hi(a.y) + bf_hi(b.y), bf_lo(a.z) + bf_lo(b.z), bf_hi(a.z) + bf_hi(b.z), bf_lo(a.w) + bf_lo(b.w), bf_hi(a.w) + bf_hi(b.w)};
        const float zf[8] = {bf_lo(zz.x), bf_hi(zz.x), bf_lo(zz.y), bf_hi(zz.y), bf_lo(zz.z), bf_hi(zz.z), bf_lo(zz.w), bf_hi(zz.w)};
        float ss = 0.f;
#pragma unroll
        for (int e = 0; e < 8; ++e) ss += o[e] * o[e];
        ss += __shfl_xor(ss, 1); ss += __shfl_xor(ss, 2); ss += __shfl_xor(ss, 4); ss += __shfl_xor(ss, 8);
        const float r = rsqrtf(ss * (1.f / 128.f) + 1e-6f);
        float y[8];
#pragma unroll
        for (int e = 0; e < 8; ++e) y[e] = o[e] * r * (e < 4 ? w0[e] : w1[e - 4]) * silu_f(zf[e]);
        u32x4 v; v.x = cvt_pk_bf16(y[0], y[1]); v.y = cvt_pk_bf16(y[2], y[3]); v.z = cvt_pk_bf16(y[4], y[5]); v.w = cvt_pk_bf16(y[6], y[7]);
        *(u32x4*)(dst + off) = v;
    }
}

__device__ __forceinline__ void ffn_act_phase(const int tid, const bf16_t* __restrict__ up, bf16_t* __restrict__ hmid, const float* __restrict__ cw, const float* __restrict__ cb, int slab_row0) {
    constexpr int RUN = 32, NCG = 352, NITEM = NCG * (16384 / RUN);
    for (int it = blockIdx.x * NTHR + tid; it < NITEM; it += gridDim.x * NTHR) {
        const int cgp = it % NCG, run = it / NCG, c = cgp * 8, lr0 = run * RUN;
        int s0, s1; seq_bounds(slab_row0 + lr0, s0, s1); s0 -= slab_row0; s1 -= slab_row0;
        float wv[3][8], wg[3][8], bv[8], bg[8];
#pragma unroll
        for (int i = 0; i < 3; ++i)
#pragma unroll
            for (int e = 0; e < 8; ++e) { wv[i][e] = cw[i * 5632 + c + e]; wg[i][e] = cw[i * 5632 + 2816 + c + e]; }
#pragma unroll
        for (int e = 0; e < 8; ++e) { bv[e] = cb[c + e]; bg[e] = cb[2816 + c + e]; }
        const u32x4 zero = (u32x4){0u, 0u, 0u, 0u};
        u32x4 pv, pg, cv, cgt, nv, ng;
        if (lr0 - 1 >= s0) { pv = *(const u32x4*)(up + (size_t)(lr0 - 1) * 5632 + c); pg = *(const u32x4*)(up + (size_t)(lr0 - 1) * 5632 + 2816 + c); } else { pv = zero; pg = zero; }
        cv = *(const u32x4*)(up + (size_t)lr0 * 5632 + c); cgt = *(const u32x4*)(up + (size_t)lr0 * 5632 + 2816 + c);
        for (int r = 0; r < RUN; ++r) {
            const int lr = lr0 + r;
            if (lr + 1 < s1) { nv = *(const u32x4*)(up + (size_t)(lr + 1) * 5632 + c); ng = *(const u32x4*)(up + (size_t)(lr + 1) * 5632 + 2816 + c); } else { nv = zero; ng = zero; }
            float y[8];
#pragma unroll
            for (int e2 = 0; e2 < 4; ++e2) {
                const unsigned a0 = e2 == 0 ? pv.x : e2 == 1 ? pv.y : e2 == 2 ? pv.z : pv.w, a1 = e2 == 0 ? cv.x : e2 == 1 ? cv.y : e2 == 2 ? cv.z : cv.w, a2 = e2 == 0 ? nv.x : e2 == 1 ? nv.y : e2 == 2 ? nv.z : nv.w;
                const unsigned g0 = e2 == 0 ? pg.x : e2 == 1 ? pg.y : e2 == 2 ? pg.z : pg.w, g1 = e2 == 0 ? cgt.x : e2 == 1 ? cgt.y : e2 == 2 ? cgt.z : cgt.w, g2 = e2 == 0 ? ng.x : e2 == 1 ? ng.y : e2 == 2 ? ng.z : ng.w;
                const int e = 2 * e2;
                const float v0 = bv[e] + wv[0][e] * bf_lo(a0) + wv[1][e] * bf_lo(a1) + wv[2][e] * bf_lo(a2), v1 = bv[e + 1] + wv[0][e + 1] * bf_hi(a0) + wv[1][e + 1] * bf_hi(a1) + wv[2][e + 1] * bf_hi(a2);
                const float q0 = bg[e] + wg[0][e] * bf_lo(g0) + wg[1][e] * bf_lo(g1) + wg[2][e] * bf_lo(g2), q1 = bg[e + 1] + wg[0][e + 1] * bf_hi(g0) + wg[1][e + 1] * bf_hi(g1) + wg[2][e + 1] * bf_hi(g2);
                y[e] = silu_f(q0) * v0; y[e + 1] = silu_f(q1) * v1;
            }
            u32x4 v; v.x = cvt_pk_bf16(y[0], y[1]); v.y = cvt_pk_bf16(y[2], y[3]); v.z = cvt_pk_bf16(y[4], y[5]); v.w = cvt_pk_bf16(y[6], y[7]);
            *(u32x4*)(hmid + (size_t)lr * 2816 + c) = v;
            pv = cv; pg = cgt; cv = nv; cgt = ng;
        }
    }
}

__device__ __forceinline__ int t5_bucket_abs(int n) { return n < 8 ? n : (n < 15 ? 8 : n < 27 ? 9 : n < 50 ? 10 : n < 91 ? 11 : n < 166 ? 12 : n < 305 ? 13 : n < 559 ? 14 : 15); }
constexpr int A_VT = 0, A_VTP = 392  , A_BIAS = 64 * A_VTP * 2;
__device__ __forceinline__ void attn_phase(const int tid0, ldsp L, const Params& p, const bf16_t* __restrict__ qkv, bf16_t* __restrict__ ao, float* __restrict__ lse) {
    LAS float* BT = (LAS float*)(L + A_BIAS);
    const float* rel_bias = p.in[13];
    for (int it = blockIdx.x; it < (MTOK / 256) * 12; it += gridDim.x) {
        int tid; asm volatile("v_mov_b32 %0, %1" : "=v"(tid) : "v"(tid0));
        const int wid = __builtin_amdgcn_readfirstlane(tid >> 6), lane = tid & 63, n32 = lane & 31, h2 = lane >> 5;
        const int tb = it / 12, head = it % 12, g = head >> 2, dsh = 2 * g, d = 1 << dsh;
        int s0, Ts, lb;
        if (tb < 64) { s0 = 0; Ts = TPROMPT; lb = tb; } else { s0 = TPROMPT + ((tb - 64) >> 4) * TSAMP; Ts = TSAMP; lb = (tb - 64) & 15; }
        const int Lq = Ts >> dsh, r = lb & (d - 1), st = lb >> dsh, p0 = 256 * st;
        __syncthreads();
        if (tid < 129) { const int rel = (tid - 64) * d, n = rel < 0 ? -rel : rel; BT[tid] = rel_bias[((rel > 0 ? 16 : 0) + t5_bucket_abs(n)) * 12 + head]; }
#pragma unroll
        for (int i = 0; i < 6; ++i) {
            const int idx = tid + NTHR * i, key = idx >> 3, ch = idx & 7; int pk = p0 - 64 + key; pk = pk < 0 ? 0 : (pk >= Lq ? Lq - 1 : pk);
            const u32x4 v = *(const u32x4*)(qkv + (size_t)(s0 + (pk << dsh) + r) * 2304 + 1536 + head * 64 + ch * 8);
            LAS unsigned short* vt = (LAS unsigned short*)(L + A_VT) + (ch * 8) * A_VTP + key;
            vt[0] = (unsigned short)(v.x & 0xffffu); vt[A_VTP] = (unsigned short)(v.x >> 16); vt[2 * A_VTP] = (unsigned short)(v.y & 0xffffu); vt[3 * A_VTP] = (unsigned short)(v.y >> 16);
            vt[4 * A_VTP] = (unsigned short)(v.z & 0xffffu); vt[5 * A_VTP] = (unsigned short)(v.z >> 16); vt[6 * A_VTP] = (unsigned short)(v.w & 0xffffu); vt[7 * A_VTP] = (unsigned short)(v.w >> 16);
        }
        const int qp = p0 + 32 * wid + n32; const size_t qtok = (size_t)(s0 + (qp << dsh) + r);
        bf16x8 qf[4];
#pragma unroll
        for (int kk = 0; kk < 4; ++kk) qf[kk] = *(const bf16x8*)(qkv + qtok * 2304 + head * 64 + 16 * kk + 8 * h2);
        f32x16 sc[5];
#pragma unroll
        for (int jt = 0; jt < 5; ++jt) {
            int kp = p0 + 32 * wid - 64 + 32 * jt + n32; kp = kp < 0 ? 0 : (kp >= Lq ? Lq - 1 : kp);
            const bf16_t* kr = qkv + (size_t)(s0 + (kp << dsh) + r) * 2304 + 768 + head * 64 + 8 * h2;
            f32x16 a;
#pragma unroll
            for (int e = 0; e < 16; ++e) a[e] = 0.f;
#pragma unroll
            for (int kk = 0; kk < 4; ++kk) a = MFMA32(*(const bf16x8*)(kr + 16 * kk), qf[kk], a);
            sc[jt] = a;
        }
        __syncthreads();
        float mx = -3.0e38f;
#pragma unroll
        for (int jt = 0; jt < 5; ++jt)
#pragma unroll
            for (int e = 0; e < 16; ++e) {
                const int m = (e & 3) + 8 * (e >> 2) + 4 * h2, rel = 32 * jt - 64 + m - n32, kp = qp + rel;
                const bool ok = rel >= -64 && rel <= 64 && kp >= 0 && kp < Lq;
                const float lg = ok ? sc[jt][e] * 0.125f + BT[ok ? rel + 64 : 64] : -1.0e30f;
                sc[jt][e] = lg; mx = fmaxf(mx, lg);
            }
        mx = fmaxf(mx, __shfl_xor(mx, 32));
        float sum = 0.f;
#pragma unroll
        for (int jt = 0; jt < 5; ++jt)
#pragma unroll
            for (int e = 0; e < 16; ++e) { const float pe = sc[jt][e] > -1.0e29f ? __expf(sc[jt][e] - mx) : 0.f; sc[jt][e] = pe; sum += pe; }
        sum += __shfl_xor(sum, 32);
        f32x16 ot[2];
#pragma unroll
        for (int dt = 0; dt < 2; ++dt)
#pragma unroll
            for (int e = 0; e < 16; ++e) ot[dt][e] = 0.f;
#pragma unroll
        for (int jt = 0; jt < 5; ++jt)
#pragma unroll
            for (int s2 = 0; s2 < 2; ++s2) {
                u32x4 pb; pb.x = cvt_pk_bf16(sc[jt][8 * s2 + 0], sc[jt][8 * s2 + 1]); pb.y = cvt_pk_bf16(sc[jt][8 * s2 + 2], sc[jt][8 * s2 + 3]); pb.z = cvt_pk_bf16(sc[jt][8 * s2 + 4], sc[jt][8 * s2 + 5]); pb.w = cvt_pk_bf16(sc[jt][8 * s2 + 6], sc[jt][8 * s2 + 7]);
                const int kb = 32 * wid + 32 * jt + 16 * s2 + 4 * h2;
#pragma unroll
                for (int dt = 0; dt < 2; ++dt) {
                    ldsp vp = L + A_VT + ((32 * dt + n32) * A_VTP + kb) * 2;
                    const u32x2 lo = *(LAS const u32x2*)vp, hi = *(LAS const u32x2*)(vp + 16); u32x4 va; va.x = lo.x; va.y = lo.y; va.z = hi.x; va.w = hi.y;
                    ot[dt] = MFMA32(as_bf16x8(va), as_bf16x8(pb), ot[dt]);
                }
            }
        const float inv = 1.f / sum;
        bf16_t* orow = ao + qtok * 768 + head * 64;
#pragma unroll
        for (int dt = 0; dt < 2; ++dt)
#pragma unroll
            for (int g4 = 0; g4 < 4; ++g4) { u32x2 v; v.x = cvt_pk_bf16(ot[dt][4 * g4] * inv, ot[dt][4 * g4 + 1] * inv); v.y = cvt_pk_bf16(ot[dt][4 * g4 + 2] * inv, ot[dt][4 * g4 + 3] * inv);
                *(u32x2*)(orow + 32 * dt + 8 * g4 + 4 * h2) = v; }
        if (h2 == 0) lse[qtok * 12 + head] = mx + __logf(sum);
    }
}
__device__ __forceinline__ void attn_combine_phase(const int tid, const bf16_t* __restrict__ ao, const float* __restrict__ lse, bf16_t* __restrict__ dst) {
    for (size_t e = (size_t)blockIdx.x * NTHR + tid; e < (size_t)MTOK * 96; e += (size_t)gridDim.x * NTHR) {
        const size_t t = e / 96; const int c8 = (int)(e % 96), head = c8 >> 3, i = head & 3;
        const float l0 = lse[t * 12 + i], l1 = lse[t * 12 + 4 + i], l2 = lse[t * 12 + 8 + i], lh = lse[t * 12 + head];
        const float m = fmaxf(l0, fmaxf(l1, l2)), al = __expf(lh - m) / (__expf(l0 - m) + __expf(l1 - m) + __expf(l2 - m));
        const u32x4 a = *(const u32x4*)(ao + e * 8);
        u32x4 v; v.x = cvt_pk_bf16(bf_lo(a.x) * al, bf_hi(a.x) * al); v.y = cvt_pk_bf16(bf_lo(a.y) * al, bf_hi(a.y) * al); v.z = cvt_pk_bf16(bf_lo(a.z) * al, bf_hi(a.z) * al); v.w = cvt_pk_bf16(bf_lo(a.w) * al, bf_hi(a.w) * al);
        *(u32x4*)(dst + e * 8) = v;
    }
}

struct EpiBf16Any {
    static constexpr bool PERM = true, AFTER_DRAIN = false;
    bf16_t* O; int ldc; int gdn; bf16_t* z; float* gates;
    __device__ __forceinline__ void operator()(const f32x4 (&acc)[2][2][4][2], const Unit& u, int wr, int wc, int fr, int fq) const {
        const int row0 = u.pm * 256 + wr * 64 + fr;
        bf16_t* base = O; int ld = ldc, colt = u.pn * 256;
        if (gdn) {
            if (u.pn >= 16) {
                if (wc == 0) {
#pragma unroll
                    for (int ai = 0; ai < 2; ++ai)
#pragma unroll
                        for (int m = 0; m < 4; ++m) { float* g = gates + (size_t)(row0 + ai * 128 + m * 16) * 32 + 8 * fq; *(f32x4*)g = acc[ai][0][m][0]; *(f32x4*)(g + 4) = acc[ai][0][m][1]; }
                }
                return;
            }
            if (u.pn >= 12) { base = z; ld = 1024; colt = (u.pn - 12) * 256; }
        }
        const int col0 = colt + wc * 32 + 8 * fq;
#pragma unroll
        for (int ai = 0; ai < 2; ++ai)
#pragma unroll
            for (int m = 0; m < 4; ++m) { bf16_t* rowp = base + (size_t)(row0 + ai * 128 + m * 16) * ld + col0;
#pragma unroll
                for (int bj = 0; bj < 2; ++bj) { const f32x4 v0 = acc[ai][bj][m][0], v1 = acc[ai][bj][m][1]; u32x4 o; o.x = cvt_pk_bf16(v0[0], v0[1]); o.y = cvt_pk_bf16(v0[2], v0[3]); o.z = cvt_pk_bf16(v1[0], v1[1]); o.w = cvt_pk_bf16(v1[2], v1[3]);
                    *(u32x4*)(rowp + bj * 128) = o; }
                asm volatile("" ::: "memory"); }
    }
};

enum { K_PREP = 0, K_RMS, K_GEMM_BF16, K_GEMM_RESID, K_GDN, K_GDNCOMB, K_ACT, K_ATT, K_ATTCOMB, K_FINAL };
constexpr int NPHASE = 44;
__device__ __forceinline__ void decode_phase(int ph, int& kind, int& which, int& layer, int& slab, bool& sync) {
    layer = 0; slab = 0; which = 0; sync = true;
    if (ph == 0) { kind = K_PREP; sync = false; }
    else if (ph == 1) { kind = K_RMS; which = 0; }
    else if (ph == 2) { kind = K_GEMM_BF16; which = 0; }
    else if (ph == 3) kind = K_GDN;
    else if (ph == 4) kind = K_GDNCOMB;
    else if (ph == 5) { kind = K_GEMM_RESID; which = 0; }
    else if (ph == 6) { kind = K_RMS; which = 1; }
    else if (ph < 22) { const int q = ph - 7; slab = q / 3; const int r = q % 3; layer = 0; which = 1; kind = r == 0 ? K_GEMM_BF16 : (r == 1 ? K_ACT : K_GEMM_RESID); sync = (r != 2) || slab == 4; }
    else if (ph == 22) { kind = K_RMS; which = 2; }
    else if (ph == 23) { kind = K_GEMM_BF16; which = 2; }
    else if (ph == 24) kind = K_ATT;
    else if (ph == 25) kind = K_ATTCOMB;
    else if (ph == 26) { kind = K_GEMM_RESID; which = 2; }
    else if (ph == 27) { kind = K_RMS; which = 3; }
    else if (ph < 43) { const int q = ph - 28; slab = q / 3; const int r = q % 3; layer = 1; which = 1; kind = r == 0 ? K_GEMM_BF16 : (r == 1 ? K_ACT : K_GEMM_RESID); sync = (r != 2) || slab == 4; }
    else { kind = K_FINAL; sync = false; }
}

__global__ void __launch_bounds__(512, 2) mega_fwd(Params p) {
    extern __shared__ __attribute__((aligned(16))) unsigned char shm[];
    ldsp L = (ldsp)shm;
    cg::grid_group grid = cg::this_grid();
    for (int ph = 0; ph < NPHASE; ++ph) {
        int tid; asm volatile("v_mov_b32 %0, %1" : "=v"(tid) : "v"((int)threadIdx.x));
        unsigned char* ws = p.ws;
        bf16_t* W = (bf16_t*)(ws + WS_W);
        bf16_t* R1 = (bf16_t*)(ws + WS_R1); bf16_t* R2 = (bf16_t*)(ws + WS_R2); bf16_t* R3 = (bf16_t*)(ws + WS_R3); float* R4 = (float*)(ws + WS_R4);
        bf16_t* up = R3; bf16_t* hmid = R3 + (size_t)16384 * 5632; bf16_t* ao = R3 + (size_t)MTOK * 2304;
        int kind, which, layer, slab; bool sync;
        decode_phase(ph, kind, which, layer, slab, sync);
        const int row0 = slab * 16384;
        switch (kind) {
        case K_PREP: {
            for (int wi = 0; wi < 8; ++wi) {
                const float* src; bf16_t* dst; int K, N, Np;
                switch (wi) {
                case 0: src = p.in[5]; dst = W + W_GDN_IN; K = 1024; N = 4128; Np = 4352; break;
                case 1: src = p.in[10]; dst = W + W_GDN_OUT; K = 1024; N = 1024; Np = 1024; break;
                case 2: src = p.in[11]; dst = W + W_ATT_IN; K = 1024; N = 2304; Np = 2304; break;
                case 3: src = p.in[12]; dst = W + W_ATT_OUT; K = 768; N = 1024; Np = 1024; break;
                case 4: src = p.in[14]; dst = W + W_FFN_UP; K = 1024; N = 5632; Np = 5632; break;
                case 5: src = p.in[14] + (size_t)1024 * 5632; dst = W + W_FFN_UP + (size_t)5632 * 1024; K = 1024; N = 5632; Np = 5632; break;
                case 6: src = p.in[17]; dst = W + W_FFN_DOWN; K = 2816; N = 1024; Np = 1024; break;
                default: src = p.in[17] + (size_t)2816 * 1024; dst = W + W_FFN_DOWN + (size_t)1024 * 2816; K = 2816; N = 1024; Np = 1024; break;
                }
                wt_convert(tid, L, src, dst, K, N, Np);
            }
        } break;
        case K_RMS: {
            const float* x0 = which == 0 ? p.in[0] : p.out; const float* x1 = which == 0 ? p.in[1] : p.out; const int split = which == 0 ? TPROMPT : 0x7fffffff;
            const float* w = which == 0 ? p.in[2] : (which == 1 ? p.in[3] : (which == 2 ? p.in[2] + 1024 : p.in[3] + 1024));
            rmsnorm_phase<false>(tid, x0, x1, split, w, R1, nullptr);
        } break;
        case K_GEMM_BF16: {
            EpiBf16Any E; E.gdn = 0; E.z = R2; E.gates = R4; const bf16_t* A; const bf16_t* Bt; int M, N;
            if (which == 0) { A = R1; Bt = W + W_GDN_IN; M = MTOK; N = 4352; E.O = R3; E.ldc = 3072; E.gdn = 1; }
            else if (which == 1) { A = R1 + (size_t)row0 * 1024; Bt = W + W_FFN_UP + (size_t)layer * 5632 * 1024; M = 16384; N = 5632; E.O = up; E.ldc = 5632; }
            else { A = R1; Bt = W + W_ATT_IN; M = MTOK; N = 2304; E.O = R3; E.ldc = 2304; }
            run_gemm(tid, L, A, Bt, M, N, 1024, E);
        } break;
        case K_GEMM_RESID: {
            EpiResid E; const bf16_t* A; const bf16_t* Bt; int M, K;
            if (which == 0) { A = R3; Bt = W + W_GDN_OUT; M = MTOK; K = 1024; E.out = p.out; E.r0 = p.in[0]; E.r1 = p.in[1]; E.split = TPROMPT; }
            else if (which == 1) { A = hmid; Bt = W + W_FFN_DOWN + (size_t)layer * 1024 * 2816; M = 16384; K = 2816; E.out = p.out + (size_t)row0 * 1024; E.r0 = E.out; E.r1 = E.out; E.split = 0x7fffffff; }
            else { A = R2; Bt = W + W_ATT_OUT; M = MTOK; K = 768; E.out = p.out; E.r0 = p.out; E.r1 = p.out; E.split = 0x7fffffff; }
            run_gemm(tid, L, A, Bt, M, 1024, K, E);
        } break;
#ifndef NO_GDN
        case K_GDN: gdn_scan_phase(tid, L, p, R3, R4, R1, (bf16_t*)p.out); break;
#endif
        case K_GDNCOMB: gdn_combine_phase(tid, p, R1, (const bf16_t*)p.out, R2, R3); break;
#ifndef NO_ACT
        case K_ACT: ffn_act_phase(tid, up, hmid, p.in[15] + (size_t)layer * 3 * 5632, p.in[16] + (size_t)layer * 5632, row0); break;
#endif
#ifndef NO_ATT
        case K_ATT: attn_phase(tid, L, p, R3, ao, R4); break;
#endif
        case K_ATTCOMB: attn_combine_phase(tid, ao, R4, R2); break;
        default: rmsnorm_phase<true>(tid, p.out, p.out, 0x7fffffff, p.in[4], nullptr, p.out); break;
        }
        if (sync) grid.sync();
    }
}

extern "C" void kernel_launch(void* const* d_in, const int* in_sizes, int n_in, void* d_out, int out_size, void* d_ws, size_t ws_size, hipStream_t stream) {
    static int grid_blocks = 0;
    if (grid_blocks == 0) {
        if (n_in != 18 || ws_size < WS_END) { fprintf(stderr, "kernel_launch: unexpected n_in %d / ws_size %zu\n", n_in, ws_size); grid_blocks = -1; return; }
        int dev = 0, cus = 0, per_cu = 0;
        hipGetDevice(&dev); hipDeviceGetAttribute(&cus, hipDeviceAttributeMultiprocessorCount, dev);
        if (hipFuncSetAttribute((const void*)mega_fwd, hipFuncAttributeMaxDynamicSharedMemorySize, LDS_BYTES) != hipSuccess) { fprintf(stderr, "kernel_launch: hipFuncSetAttribute failed\n"); grid_blocks = -1; return; }
        if (hipOccupancyMaxActiveBlocksPerMultiprocessor(&per_cu, (const void*)mega_fwd, NTHR, LDS_BYTES) != hipSuccess || per_cu < 1) { fprintf(stderr, "kernel_launch: occupancy query gave %d\n", per_cu); per_cu = 1; }
        (void)hipGetLastError();
        grid_blocks = cus;
    }
    if (grid_blocks < 0) return;
    Params p{};
    for (int i = 0; i < 18; ++i) p.in[i] = (const float*)d_in[i];
    p.out = (float*)d_out; p.ws = (unsigned char*)d_ws;
    void* args[] = {&p};
    hipError_t e = hipLaunchCooperativeKernel((const void*)mega_fwd, dim3(grid_blocks), dim3(NTHR), args, LDS_BYTES, stream);
    if (e != hipSuccess) fprintf(stderr, "cooperative launch failed: %s (grid %d)\n", hipGetErrorString(e), grid_blocks);
}
```

```cpp
#include <hip/hip_runtime.h>
#include <hip/hip_cooperative_groups.h>
#include <cstdio>
namespace cg = cooperative_groups;
namespace pg8 {
#define PG8_LAS __attribute__((address_space(3)))
typedef unsigned short bf16_t;
typedef short bf16x8 __attribute__((ext_vector_type(8)));
typedef float f32x4 __attribute__((ext_vector_type(4)));
typedef unsigned u32x4 __attribute__((ext_vector_type(4)));
constexpr int BM = 256, BK = 64, HALF = 128, HTB = HALF * BK * 2  , STAGE_BYTES = 8 * HTB, NXCD = 8, WGM = 8;

__host__ __device__ __forceinline__ int lds_byte(int r, int c) { const int st = (r >> 4) * 2 + (c >> 5), rr = r & 15, cc = c & 31, ob = rr * 64 + cc * 2; return st * 1024 + (ob ^ (((ob >> 9) & 1) << 5)); }
__host__ __device__ __forceinline__ void stage_rc(int b, int& R, int& C) { const int st = b / 1024, sb = b % 1024, swz = sb ^ (((sb >> 9) & 1) << 5); R = (st >> 1) * 16 + swz / 64; C = (st & 1) * 32 + (swz % 64) / 2; }
__host__ __device__ __forceinline__ int perm32(int rho) { const int n = rho >> 4, i = rho & 15; return 8 * (i >> 2) + 4 * n + (i & 3); }

struct Unit { int pm, pn; };
struct Gemm { const bf16_t* A; const bf16_t* Bt; int M, N, K; };
struct StaticOrder {
    int nM, nN, nwg, G, c;
    __host__ __device__ void init(int M, int N, int G_, int c_) { nM = M / BM; nN = N / BM; nwg = nM * nN; G = G_; c = c_; }
    __host__ __device__ bool next(int i, Unit& u) const {
        const long L = (long)i * G + c; if (L >= nwg) return false;
        int wgid = (int)L; { const int q = nwg / NXCD, r = nwg % NXCD, xcd = wgid % NXCD, off = wgid / NXCD; wgid = (xcd < r ? xcd * (q + 1) : r * (q + 1) + (xcd - r) * q) + off; }
        const int nig = WGM * nN, gid = wgid / nig, fm = gid * WGM, gsz = (nM - fm) < WGM ? (nM - fm) : WGM;
        u.pm = fm + ((wgid % nig) % gsz); u.pn = (wgid % nig) / gsz; return true;
    }
    __device__ __forceinline__ void a_ready(const Unit&) const {}
    __device__ __forceinline__ void done(const Unit&) const {}
};
__device__ __forceinline__ unsigned cvt_pk_bf16(float lo, float hi) { unsigned r; asm volatile("v_cvt_pk_bf16_f32 %0, %1, %2" : "=v"(r) : "v"(lo), "v"(hi)); return r; }
template <class Epi, class Sched>
__device__ __forceinline__ void gemm_phase(PG8_LAS unsigned char* lds, const Gemm g, const Sched& S, const Epi& E, const int tid_in) {
    const int tid = tid_in, wid = __builtin_amdgcn_readfirstlane(tid >> 6), lane = tid & 63, wr = wid >> 2, wc = wid & 3, fr = lane & 15, fq = lane >> 4;
    const int K = g.K, nt = K / BK;
    unsigned voffA[2], voffB[2];
#pragma unroll
    for (int i = 0; i < 2; ++i) { int R, C; stage_rc(tid * 16 + i * 8192, R, C); const int Rb = Epi::PERM ? ((R & ~31) + perm32(R & 31)) : R;
        voffA[i] = (unsigned)(R * K + C) * 2u; voffB[i] = (unsigned)(Rb * K + C) * 2u; }
    const size_t kstep = (size_t)(BK * 2);
    const size_t hstep = (size_t)HALF * K * 2;
    const size_t tstep = 2 * hstep;
    const unsigned ldsw = (unsigned)wid * 1024u;
    const int aoff = lds_byte(wr * 64 + fr, fq * 8), boff = lds_byte(wc * 32 + fr, fq * 8);
#define PG8_SA(b, h) (((b) * 2 + (h)) * HTB)
#define PG8_SB(b, h) ((4 + (b) * 2 + (h)) * HTB)
#define PG8_STAGE(bufoff, gbase, voff) do { _Pragma("unroll") for (int _i = 0; _i < 2; ++_i) \
        __builtin_amdgcn_global_load_lds((const unsigned*)((const char*)(gbase) + (voff)[_i]), (PG8_LAS unsigned*)(lds + (bufoff) + ldsw + _i * 8192), 16, 0, 0); } while (0)
#define PG8_LDA(dst, b, h) do { _Pragma("unroll") for (int m = 0; m < 4; ++m) _Pragma("unroll") for (int k = 0; k < 2; ++k) dst[m][k] = *(const PG8_LAS bf16x8*)(lds + PG8_SA(b, h) + aoff + m * 2048 + k * 1024); } while (0)
#define PG8_LDB(dst, b, h) do { _Pragma("unroll") for (int n = 0; n < 2; ++n) _Pragma("unroll") for (int k = 0; k < 2; ++k) dst[n][k] = *(const PG8_LAS bf16x8*)(lds + PG8_SB(b, h) + boff + n * 2048 + k * 1024); } while (0)
#define PG8_MMA(ai, bj, At, Bt) do { __builtin_amdgcn_s_setprio(1); _Pragma("unroll") for (int m = 0; m < 4; ++m) _Pragma("unroll") for (int n = 0; n < 2; ++n) _Pragma("unroll") for (int k = 0; k < 2; ++k) \
        acc[ai][bj][m][n] = __builtin_amdgcn_mfma_f32_16x16x32_bf16(Bt[n][k], At[m][k], acc[ai][bj][m][n], 0, 0, 0); __builtin_amdgcn_s_setprio(0); } while (0)
#define PG8_WAIT_V(n) asm volatile("s_waitcnt vmcnt(" #n ")" ::: "memory")
#define PG8_WAIT_L(n) asm volatile("s_waitcnt lgkmcnt(" #n ")" ::: "memory")
#define PG8_BAR __builtin_amdgcn_s_barrier()
#define PG8_SCHED __builtin_amdgcn_sched_barrier(0)
    Unit cur, nxt; int ui = 0;
    if (!S.next(0, cur)) return;
    f32x4 acc[2][2][4][2];
#pragma unroll
    for (int a = 0; a < 2; ++a)
#pragma unroll
        for (int b = 0; b < 2; ++b)
#pragma unroll
            for (int m = 0; m < 4; ++m)
#pragma unroll
                for (int n = 0; n < 2; ++n) acc[a][b][m][n] = (f32x4){0.f, 0.f, 0.f, 0.f};
    bf16x8 At[4][2], B0[2][2], B1[2][2];
    const char* cA = (const char*)g.A + (size_t)cur.pm * tstep; const char* cB = (const char*)g.Bt + (size_t)cur.pn * tstep;
    S.a_ready(cur);
    PG8_STAGE(PG8_SB(0, 0), cB, voffB); PG8_STAGE(PG8_SA(0, 0), cA, voffA); PG8_STAGE(PG8_SB(0, 1), cB + hstep, voffB); PG8_STAGE(PG8_SA(0, 1), cA + hstep, voffA);
    if (wr == 1) PG8_BAR;
    PG8_WAIT_V(4); PG8_BAR;
    PG8_STAGE(PG8_SB(1, 0), cB + kstep, voffB); PG8_STAGE(PG8_SA(1, 0), cA + kstep, voffA); PG8_STAGE(PG8_SB(1, 1), cB + hstep + kstep, voffB);
    PG8_WAIT_V(6); PG8_BAR;
    for (;;) {
        const bool has_next = S.next(ui + 1, nxt);
        const char* nA = has_next ? (const char*)g.A + (size_t)nxt.pm * tstep : cA; const char* nB = has_next ? (const char*)g.Bt + (size_t)nxt.pn * tstep : cB;
        for (int t = 0; t < nt; t += 2) {
            const bool last = (t == nt - 2);
            const char* a1 = cA + (size_t)(t + 1) * kstep;
            const char* a2 = last ? nA : cA + (size_t)(t + 2) * kstep; const char* b2 = last ? nB : cB + (size_t)(t + 2) * kstep;
            const char* a3 = a2 + kstep; const char* b3 = b2 + kstep;
            if (last && has_next) S.a_ready(nxt);
            PG8_LDB(B0, 0, 0); PG8_SCHED; PG8_LDA(At, 0, 0); PG8_STAGE(PG8_SA(1, 1), a1 + hstep, voffA);
            PG8_WAIT_L(8); PG8_BAR; PG8_WAIT_L(0); PG8_MMA(0, 0, At, B0); PG8_BAR; PG8_SCHED;
            PG8_LDB(B1, 0, 1); PG8_STAGE(PG8_SB(0, 0), b2, voffB);
            PG8_BAR; PG8_WAIT_L(0); PG8_MMA(0, 1, At, B1); PG8_BAR;
            PG8_LDA(At, 0, 1); PG8_STAGE(PG8_SA(0, 0), a2, voffA);
            PG8_BAR; PG8_WAIT_L(0); PG8_MMA(1, 0, At, B0); PG8_BAR; PG8_SCHED;
            PG8_STAGE(PG8_SB(0, 1), b2 + hstep, voffB);
            PG8_WAIT_V(6); PG8_BAR; PG8_MMA(1, 1, At, B1); PG8_BAR;
            PG8_LDB(B0, 1, 0); PG8_SCHED; PG8_LDA(At, 1, 0); PG8_STAGE(PG8_SA(0, 1), a2 + hstep, voffA);
            PG8_WAIT_L(8); PG8_BAR; PG8_WAIT_L(0); PG8_MMA(0, 0, At, B0); PG8_BAR; PG8_SCHED;
            PG8_LDB(B1, 1, 1); PG8_STAGE(PG8_SB(1, 0), b3, voffB);
            PG8_BAR; PG8_WAIT_L(0); PG8_MMA(0, 1, At, B1); PG8_BAR;
            PG8_LDA(At, 1, 1); PG8_STAGE(PG8_SA(1, 0), a3, voffA);
            PG8_BAR; PG8_WAIT_L(0); PG8_MMA(1, 0, At, B0); PG8_BAR; PG8_SCHED;
            PG8_STAGE(PG8_SB(1, 1), b3 + hstep, voffB);
            PG8_WAIT_V(6); PG8_BAR; PG8_MMA(1, 1, At, B1); PG8_BAR;
        }
        if constexpr (!Epi::AFTER_DRAIN) { E(acc, cur, wr, wc, fr, fq); S.done(cur); }
        if (!has_next) break;
#pragma unroll
        for (int a = 0; a < 2; ++a)
#pragma unroll
            for (int b = 0; b < 2; ++b)
#pragma unroll
                for (int m = 0; m < 4; ++m)
#pragma unroll
                    for (int n = 0; n < 2; ++n) acc[a][b][m][n] = (f32x4){0.f, 0.f, 0.f, 0.f};
        cur = nxt; cA = nA; cB = nB; ++ui;
    }
    PG8_WAIT_V(0);
    if (wr == 0) PG8_BAR;
    PG8_BAR;
    if constexpr (Epi::AFTER_DRAIN) { E.fused(acc, cur, wr, wc, fr, fq, lds, wid, lane); S.done(cur); }
#undef PG8_SA
#undef PG8_SB
#undef PG8_STAGE
#undef PG8_LDA
#undef PG8_LDB
#undef PG8_MMA
#undef PG8_WAIT_V
#undef PG8_WAIT_L
#undef PG8_BAR
#undef PG8_SCHED
}
}

using pg8::bf16_t; using pg8::bf16x8; using pg8::f32x4; using pg8::u32x4; using pg8::Unit; using pg8::cvt_pk_bf16;
typedef unsigned u32x2 __attribute__((ext_vector_type(2)));
typedef float f32x16 __attribute__((ext_vector_type(16)));
#define LAS __attribute__((address_space(3)))
typedef LAS unsigned char* ldsp;

constexpr int MTOK = 81920, TPROMPT = 16384, TSAMP = 4096, DMODEL = 1024;
constexpr int LDS_BYTES = 131072 + 8192;
constexpr int LDS_XCHG = 131072;
constexpr int NTHR = 512;

constexpr size_t WS_W  = 0;
constexpr size_t WS_R1 = 67108864;
constexpr size_t WS_R2 = WS_R1 + 167772160;
constexpr size_t WS_R3 = WS_R2 + 167772160;
constexpr size_t WS_R4 = WS_R3 + 503316480;
constexpr size_t WS_HALO = WS_R4 + 10485760;
constexpr size_t WS_GSC = WS_HALO + 31481856;
constexpr size_t WS_BAR = 62914560;
constexpr size_t WS_OPF = WS_GSC + (size_t)20480 * 144 * 4;
constexpr size_t WS_OPB = WS_OPF + 33554432;
constexpr size_t WS_END = WS_OPB + 33554432;
constexpr size_t W_GDN_IN = 0, W_GDN_OUT = W_GDN_IN + (size_t)4352 * 1024, W_ATT_IN = W_GDN_OUT + (size_t)1024 * 1024, W_ATT_OUT = W_ATT_IN + (size_t)2304 * 1024,
                 W_FFN_UP = W_ATT_OUT + (size_t)1024 * 768, W_FFN_DOWN = W_FFN_UP + (size_t)2 * 5632 * 1024, W_TOTAL = W_FFN_DOWN + (size_t)2 * 1024 * 2816;
static_assert(W_TOTAL * 2 <= 62914560, "weights overflow");

struct Params { const float* in[18]; float* out; unsigned char* ws; };

__device__ __forceinline__ unsigned short f2bf(float f) { unsigned u = __float_as_uint(f); u += 0x7FFFu + ((u >> 16) & 1u); return (unsigned short)(u >> 16); }
__device__ __forceinline__ float bf_lo(unsigned u) { return __uint_as_float(u << 16); }
__device__ __forceinline__ float bf_hi(unsigned u) { return __uint_as_float(u & 0xffff0000u); }
__device__ __forceinline__ float bf2f(unsigned short b) { return __uint_as_float(((unsigned)b) << 16); }
__device__ __forceinline__ float silu_f(float v) { return v * __builtin_amdgcn_rcpf(1.f + __expf(-v)); }
__device__ __forceinline__ bf16x8 as_bf16x8(u32x4 v) { union { u32x4 u; bf16x8 b; } c; c.u = v; return c.b; }
__device__ __forceinline__ bf16x8 pack8(f32x4 a, f32x4 b) { u32x4 v; v.x = cvt_pk_bf16(a[0], a[1]); v.y = cvt_pk_bf16(a[2], a[3]); v.z = cvt_pk_bf16(b[0], b[1]); v.w = cvt_pk_bf16(b[2], b[3]); return as_bf16x8(v); }
__device__ __forceinline__ bf16x8 lds_read2(ldsp p) { const u32x2 lo = *(LAS const u32x2*)p, hi = *(LAS const u32x2*)(p + 32); u32x4 v; v.x = lo.x; v.y = lo.y; v.z = hi.x; v.w = hi.y; return as_bf16x8(v); }
__device__ __forceinline__ void seq_bounds(int t, int& s0, int& s1) { if (t < TPROMPT) { s0 = 0; s1 = TPROMPT; } else { s0 = t & ~(TSAMP - 1); s1 = s0 + TSAMP; } }
#define FENCE() do { asm volatile("" ::: "memory"); __builtin_amdgcn_sched_barrier(0); } while (0)
__device__ __forceinline__ float dpp_prev16(float x) { return __int_as_float(__builtin_amdgcn_update_dpp(0, __float_as_int(x), 0x121, 0xF, 0xF, true)); }
__device__ __forceinline__ float dpp_next16(float x) { return __int_as_float(__builtin_amdgcn_update_dpp(0, __float_as_int(x), 0x12F, 0xF, 0xF, true)); }
#define MFMA16(a, b, c) __builtin_amdgcn_mfma_f32_16x16x32_bf16((a), (b), (c), 0, 0, 0)
#define MFMA32(a, b, c) __builtin_amdgcn_mfma_f32_32x32x16_bf16((a), (b), (c), 0, 0, 0)

__device__ __forceinline__ void wt_convert(const int tid, ldsp L, const float* __restrict__ w, bf16_t* __restrict__ bt, int K, int N, int Npad, int pairperm, int tstart, int tstride) {
    LAS float* tile = (LAS float*)L;
    const int nkt = K / 64, nnt = Npad / 64, ntile = nkt * nnt;
    for (int t = tstart; t < ntile; t += tstride) {
        const int kt = t % nkt, nt_ = t / nkt, k0 = kt * 64, n0 = nt_ * 64, s0n = pairperm ? (((n0 >> 7) & 1) * 2816 + (n0 >> 8) * 128 + (n0 & 127)) : n0;
#pragma unroll
        for (int i = 0; i < 8; ++i) { const int idx = tid + NTHR * i, kk = idx >> 6, nn = idx & 63; tile[kk * 65 + nn] = (s0n + nn < N) ? w[(size_t)(k0 + kk) * N + s0n + nn] : 0.f; }
        __syncthreads();
#pragma unroll
        for (int i = 0; i < 8; ++i) { const int idx = tid + NTHR * i, nn = idx >> 6, kk = idx & 63; bt[(size_t)(n0 + nn) * K + k0 + kk] = f2bf(tile[kk * 65 + nn]); }
        __syncthreads();
    }
}

template <bool FINAL>
__device__ __forceinline__ void rmsnorm_phase(const int tid, const float* x0, const float* x1, int split, const float* __restrict__ w, bf16_t* dst, float* fdst, const float pe = 0.f, const bf16_t* xb = nullptr) {
    const int lane = tid & 63, wid = tid >> 6;
    f32x4 wv[4];
#pragma unroll
    for (int j = 0; j < 4; ++j) wv[j] = *(const f32x4*)(w + lane * 4 + 256 * j);
    for (int row = blockIdx.x * 8 + wid; row < MTOK; row += gridDim.x * 8) {
        const float* xr = row < split ? x0 + (size_t)row * DMODEL : x1 + (size_t)(row - split) * DMODEL;
        f32x4 v[4]; float ss = 0.f;
#pragma unroll
        for (int j = 0; j < 4; ++j) { if (xb) { const u32x2 t = *(const u32x2*)(xb + (size_t)row * DMODEL + lane * 4 + 256 * j); v[j] = (f32x4){bf_lo(t.x), bf_hi(t.x), bf_lo(t.y), bf_hi(t.y)}; } else v[j] = *(const f32x4*)(xr + lane * 4 + 256 * j); ss += v[j][0] * v[j][0] + v[j][1] * v[j][1] + v[j][2] * v[j][2] + v[j][3] * v[j][3]; }
#pragma unroll
        for (int o = 32; o >= 1; o >>= 1) ss += __shfl_xor(ss, o);
        const float r = rsqrtf(ss * (1.f / 1024.f) + 1e-6f);
#pragma unroll
        for (int j = 0; j < 4; ++j) {
            const f32x4 y = v[j] * r * wv[j];
            if (FINAL) { f32x4 yy = y; yy[0] -= pe; yy[1] += pe; yy[2] -= pe; yy[3] += pe; *(f32x4*)(fdst + (size_t)row * DMODEL + lane * 4 + 256 * j) = yy; }
            else { u32x2 o2; o2.x = cvt_pk_bf16(y[0], y[1]); o2.y = cvt_pk_bf16(y[2], y[3]); *(u32x2*)(dst + (size_t)row * DMODEL + lane * 4 + 256 * j) = o2; }
        }
    }
}

__device__ __forceinline__ void rmsnorm_final_bf16_phase(const int tid, const bf16_t* __restrict__ xb, const float* __restrict__ w, float* __restrict__ out, const float pe) {
    const int lane = tid & 63, wid = tid >> 6, G8 = gridDim.x * 8;
    f32x4 wv[4];
#pragma unroll
    for (int j = 0; j < 2; ++j) { wv[2 * j] = *(const f32x4*)(w + 512 * j + lane * 8); wv[2 * j + 1] = *(const f32x4*)(w + 512 * j + lane * 8 + 4); }
    for (int rowb = blockIdx.x * 8 + wid; rowb < MTOK; rowb += 4 * G8) {
        u32x4 t[4][2];
#pragma unroll
        for (int u = 0; u < 4; ++u) { const int row = rowb + u * G8 < MTOK ? rowb + u * G8 : rowb;
#pragma unroll
            for (int j = 0; j < 2; ++j) t[u][j] = *(const u32x4*)(xb + (size_t)row * DMODEL + 512 * j + lane * 8); }
#pragma unroll
        for (int u = 0; u < 4; ++u) { const int row = rowb + u * G8;
            f32x4 v[4]; float ss = 0.f;
#pragma unroll
            for (int j = 0; j < 2; ++j) { v[2 * j] = (f32x4){bf_lo(t[u][j].x), bf_hi(t[u][j].x), bf_lo(t[u][j].y), bf_hi(t[u][j].y)}; v[2 * j + 1] = (f32x4){bf_lo(t[u][j].z), bf_hi(t[u][j].z), bf_lo(t[u][j].w), bf_hi(t[u][j].w)}; }
#pragma unroll
            for (int j = 0; j < 4; ++j) ss += v[j][0] * v[j][0] + v[j][1] * v[j][1] + v[j][2] * v[j][2] + v[j][3] * v[j][3];
#pragma unroll
            for (int o = 32; o >= 1; o >>= 1) ss += __shfl_xor(ss, o);
            const float r = rsqrtf(ss * (1.f / 1024.f) + 1e-6f);
            if (row < MTOK) {
#pragma unroll
                for (int j = 0; j < 4; ++j) { f32x4 y = v[j] * r * wv[j]; y[0] -= pe; y[1] += pe; y[2] -= pe; y[3] += pe; *(f32x4*)(out + (size_t)row * DMODEL + 512 * (j >> 1) + lane * 8 + 4 * (j & 1)) = y; }
            } }
    }
}

__device__ __forceinline__ void rmsnorm_f32in_phase(const int tid, const float* __restrict__ x0, const float* __restrict__ x1, int split, const float* __restrict__ w, bf16_t* __restrict__ dst) {
    const int lane = tid & 63, wid = tid >> 6, G8 = gridDim.x * 8;
    f32x4 wv[4];
#pragma unroll
    for (int j = 0; j < 2; ++j) { wv[2 * j] = *(const f32x4*)(w + 512 * j + lane * 8); wv[2 * j + 1] = *(const f32x4*)(w + 512 * j + lane * 8 + 4); }
    for (int rowb = blockIdx.x * 8 + wid; rowb < MTOK; rowb += 4 * G8) {
        f32x4 v[4][4];
#pragma unroll
        for (int u = 0; u < 4; ++u) { const int row = rowb + u * G8 < MTOK ? rowb + u * G8 : rowb; const float* xr = row < split ? x0 + (size_t)row * DMODEL : x1 + (size_t)(row - split) * DMODEL;
#pragma unroll
            for (int j = 0; j < 2; ++j) { v[u][2 * j] = *(const f32x4*)(xr + 512 * j + lane * 8); v[u][2 * j + 1] = *(const f32x4*)(xr + 512 * j + lane * 8 + 4); } }
#pragma unroll
        for (int u = 0; u < 4; ++u) { const int row = rowb + u * G8;
            float ss = 0.f;
#pragma unroll
            for (int j = 0; j < 4; ++j) ss += v[u][j][0] * v[u][j][0] + v[u][j][1] * v[u][j][1] + v[u][j][2] * v[u][j][2] + v[u][j][3] * v[u][j][3];
#pragma unroll
            for (int o = 32; o >= 1; o >>= 1) ss += __shfl_xor(ss, o);
            const float r = rsqrtf(ss * (1.f / 1024.f) + 1e-6f);
            if (row < MTOK) {
#pragma unroll
                for (int j = 0; j < 2; ++j) { const f32x4 y0 = v[u][2 * j] * r * wv[2 * j], y1 = v[u][2 * j + 1] * r * wv[2 * j + 1]; u32x4 o; o.x = cvt_pk_bf16(y0[0], y0[1]); o.y = cvt_pk_bf16(y0[2], y0[3]); o.z = cvt_pk_bf16(y1[0], y1[1]); o.w = cvt_pk_bf16(y1[2], y1[3]);
                    *(u32x4*)(dst + (size_t)row * DMODEL + 512 * j + lane * 8) = o; }
            } }
    }
}

__device__ __forceinline__ void rmsnorm_bf16_phase(const int tid, const bf16_t* __restrict__ xb, const float* __restrict__ w, bf16_t* __restrict__ dst) {
    const int lane = tid & 63, wid = tid >> 6, G8 = gridDim.x * 8;
    f32x4 wv[4];
#pragma unroll
    for (int j = 0; j < 2; ++j) { wv[2 * j] = *(const f32x4*)(w + 512 * j + lane * 8); wv[2 * j + 1] = *(const f32x4*)(w + 512 * j + lane * 8 + 4); }
    for (int rowb = blockIdx.x * 8 + wid; rowb < MTOK; rowb += 4 * G8) {
        u32x4 t[4][2];
#pragma unroll
        for (int u = 0; u < 4; ++u) { const int row = rowb + u * G8 < MTOK ? rowb + u * G8 : rowb;
#pragma unroll
            for (int j = 0; j < 2; ++j) t[u][j] = *(const u32x4*)(xb + (size_t)row * DMODEL + 512 * j + lane * 8); }
#pragma unroll
        for (int u = 0; u < 4; ++u) { const int row = rowb + u * G8;
            f32x4 v[4]; float ss = 0.f;
#pragma unroll
            for (int j = 0; j < 2; ++j) { v[2 * j] = (f32x4){bf_lo(t[u][j].x), bf_hi(t[u][j].x), bf_lo(t[u][j].y), bf_hi(t[u][j].y)}; v[2 * j + 1] = (f32x4){bf_lo(t[u][j].z), bf_hi(t[u][j].z), bf_lo(t[u][j].w), bf_hi(t[u][j].w)}; }
#pragma unroll
            for (int j = 0; j < 4; ++j) ss += v[j][0] * v[j][0] + v[j][1] * v[j][1] + v[j][2] * v[j][2] + v[j][3] * v[j][3];
#pragma unroll
            for (int o = 32; o >= 1; o >>= 1) ss += __shfl_xor(ss, o);
            const float r = rsqrtf(ss * (1.f / 1024.f) + 1e-6f);
            if (row < MTOK) {
#pragma unroll
                for (int j = 0; j < 2; ++j) { const f32x4 y0 = v[2 * j] * r * wv[2 * j], y1 = v[2 * j + 1] * r * wv[2 * j + 1]; u32x4 o; o.x = cvt_pk_bf16(y0[0], y0[1]); o.y = cvt_pk_bf16(y0[2], y0[3]); o.z = cvt_pk_bf16(y1[0], y1[1]); o.w = cvt_pk_bf16(y1[2], y1[3]);
                    *(u32x4*)(dst + (size_t)row * DMODEL + 512 * j + lane * 8) = o; }
            } }
    }
}

struct EpiResid {
    static constexpr bool PERM = true, AFTER_DRAIN = false;
    float* outf; bf16_t* ob; const float* r0; const float* r1; int split; const bf16_t* rb;
    __device__ __forceinline__ void load_resid(f32x4 (&rv)[2][2], int row, int col0) const {
        if (rb) { const bf16_t* rp = rb + (size_t)row * DMODEL + col0;
#pragma unroll
            for (int bj = 0; bj < 2; ++bj) { const u32x4 t = *(const u32x4*)(rp + bj * 128); rv[bj][0] = (f32x4){bf_lo(t.x), bf_hi(t.x), bf_lo(t.y), bf_hi(t.y)}; rv[bj][1] = (f32x4){bf_lo(t.z), bf_hi(t.z), bf_lo(t.w), bf_hi(t.w)}; } }
        else { const float* rp = (row < split ? r0 + (size_t)row * DMODEL : r1 + (size_t)(row - split) * DMODEL) + col0;
#pragma unroll
            for (int bj = 0; bj < 2; ++bj)
#pragma unroll
                for (int n = 0; n < 2; ++n) rv[bj][n] = *(const f32x4*)(rp + bj * 128 + n * 4); }
    }
    __device__ __forceinline__ void operator()(const f32x4 (&acc)[2][2][4][2], const Unit& u, int wr, int wc, int fr, int fq) const {
        const int row0 = u.pm * 256 + wr * 64 + fr, col0 = u.pn * 256 + wc * 32 + 8 * fq;
        f32x4 rv[2][2], rn[2][2];
        load_resid(rn, row0, col0);
#pragma unroll
        for (int g = 0; g < 8; ++g) { const int ai = g >> 2, m = g & 3, row = row0 + ai * 128 + m * 16;
#pragma unroll
            for (int bj = 0; bj < 2; ++bj)
#pragma unroll
                for (int n = 0; n < 2; ++n) rv[bj][n] = rn[bj][n];
            if (g < 7) load_resid(rn, row0 + ((g + 1) >> 2) * 128 + ((g + 1) & 3) * 16, col0);
            if (ob) { bf16_t* op = ob + (size_t)row * DMODEL + col0;
#pragma unroll
                for (int bj = 0; bj < 2; ++bj) { const f32x4 y0 = rv[bj][0] + acc[ai][bj][m][0], y1 = rv[bj][1] + acc[ai][bj][m][1]; u32x4 t; t.x = cvt_pk_bf16(y0[0], y0[1]); t.y = cvt_pk_bf16(y0[2], y0[3]); t.z = cvt_pk_bf16(y1[0], y1[1]); t.w = cvt_pk_bf16(y1[2], y1[3]);
                    *(u32x4*)(op + bj * 128) = t; } }
            else { float* op = outf + (size_t)row * DMODEL + col0;
#pragma unroll
                for (int bj = 0; bj < 2; ++bj)
#pragma unroll
                    for (int n = 0; n < 2; ++n) *(f32x4*)(op + bj * 128 + n * 4) = rv[bj][n] + acc[ai][bj][m][n]; }
            asm volatile("" ::: "memory"); }
    }
};

struct EpiFfnUp {
    static constexpr bool PERM = true, AFTER_DRAIN = false;
    bf16_t* hmid; float* raw; const float* cw; const float* cb; ldsp X;
    __device__ __forceinline__ void operator()(const f32x4 (&acc)[2][2][4][2], const Unit& u, int wr, int wc, int fr, int fq) const {
        LAS float* Xf = (LAS float*)X;
        const int cu0 = wc * 32 + 8 * fq;
#pragma unroll
        for (int ai = 0; ai < 2; ++ai) {
            if (fr == 0) {
#pragma unroll
                for (int bj = 0; bj < 2; ++bj)
#pragma unroll
                    for (int n = 0; n < 2; ++n) *(LAS f32x4*)(Xf + ((2 * ai + wr) * 2 + 0) * 256 + bj * 128 + cu0 + 4 * n) = acc[ai][bj][0][n];
            }
            if (fr == 15) {
#pragma unroll
                for (int bj = 0; bj < 2; ++bj)
#pragma unroll
                    for (int n = 0; n < 2; ++n) *(LAS f32x4*)(Xf + ((2 * ai + wr) * 2 + 1) * 256 + bj * 128 + cu0 + 4 * n) = acc[ai][bj][3][n];
            }
        }
        if (wr == 0 && fr < 2) {
#pragma unroll
            for (int bj = 0; bj < 2; ++bj)
#pragma unroll
                for (int n = 0; n < 2; ++n) *(f32x4*)(raw + ((size_t)u.pm * 4 + fr) * 5632 + bj * 2816 + u.pn * 128 + cu0 + 4 * n) = acc[0][bj][0][n];
        }
        if (wr == 1 && fr >= 14) {
#pragma unroll
            for (int bj = 0; bj < 2; ++bj)
#pragma unroll
                for (int n = 0; n < 2; ++n) *(f32x4*)(raw + ((size_t)u.pm * 4 + 2 + (fr - 14)) * 5632 + bj * 2816 + u.pn * 128 + cu0 + 4 * n) = acc[1][bj][3][n];
        }
        asm volatile("s_waitcnt lgkmcnt(0)" ::: "memory");
        __builtin_amdgcn_s_barrier();
        asm volatile("" ::: "memory");
        __builtin_amdgcn_s_barrier();
        asm volatile("" ::: "memory");
        u32x2 held[2][4];
#pragma unroll
        for (int n = 0; n < 2; ++n) {
            const int c = u.pn * 128 + cu0 + 4 * n;
            const f32x4 wv0 = *(const f32x4*)(cw + c), wv1 = *(const f32x4*)(cw + 5632 + c), wv2 = *(const f32x4*)(cw + 2 * 5632 + c), bv = *(const f32x4*)(cb + c);
            const f32x4 wg0 = *(const f32x4*)(cw + 2816 + c), wg1 = *(const f32x4*)(cw + 5632 + 2816 + c), wg2 = *(const f32x4*)(cw + 2 * 5632 + 2816 + c), bg = *(const f32x4*)(cb + 2816 + c);
#pragma unroll
            for (int ai = 0; ai < 2; ++ai) {
                const int blk = 2 * ai + wr;
                f32x4 xp[2], xn[2];
#pragma unroll
                for (int bj = 0; bj < 2; ++bj) {
                    xp[bj] = blk > 0 ? *(LAS const f32x4*)(Xf + ((blk - 1) * 2 + 1) * 256 + bj * 128 + cu0 + 4 * n) : (f32x4){0.f, 0.f, 0.f, 0.f};
                    xn[bj] = blk < 3 ? *(LAS const f32x4*)(Xf + ((blk + 1) * 2 + 0) * 256 + bj * 128 + cu0 + 4 * n) : (f32x4){0.f, 0.f, 0.f, 0.f};
                }
                f32x4 rpm1[2], rn0[2];
#pragma unroll
                for (int bj = 0; bj < 2; ++bj) {
#pragma unroll
                    for (int e = 0; e < 4; ++e) { rpm1[bj][e] = 0.f; rn0[bj][e] = dpp_next16(acc[ai][bj][0][n][e]); }
                }
#pragma unroll
                for (int m = 0; m < 4; ++m) {
                    f32x4 y[2];
#pragma unroll
                    for (int bj = 0; bj < 2; ++bj) {
                        const f32x4 cur = acc[ai][bj][m][n];
                        f32x4 rp, rn1;
#pragma unroll
                        for (int e = 0; e < 4; ++e) { rp[e] = dpp_prev16(cur[e]); rn1[e] = (m < 3) ? dpp_next16(acc[ai][bj][m < 3 ? m + 1 : 3][n][e]) : 0.f; }
                        const f32x4 pedge = (m > 0) ? rpm1[bj] : xp[bj], nedge = (m < 3) ? rn1 : xn[bj];
                        f32x4 prev, next;
#pragma unroll
                        for (int e = 0; e < 4; ++e) { prev[e] = (fr == 0) ? pedge[e] : rp[e]; next[e] = (fr == 15) ? nedge[e] : rn0[bj][e]; }
                        const f32x4 w0 = bj ? wg0 : wv0, w1 = bj ? wg1 : wv1, w2 = bj ? wg2 : wv2, b = bj ? bg : bv;
                        y[bj] = b + w0 * prev + w1 * cur + w2 * next;
                        rpm1[bj] = rp; rn0[bj] = rn1;
                    }
                    u32x2 o; o.x = cvt_pk_bf16(silu_f(y[1][0]) * y[0][0], silu_f(y[1][1]) * y[0][1]); o.y = cvt_pk_bf16(silu_f(y[1][2]) * y[0][2], silu_f(y[1][3]) * y[0][3]);
                    if (n == 0) held[ai][m] = o;
                    else { u32x4 o4; o4.x = held[ai][m].x; o4.y = held[ai][m].y; o4.z = o.x; o4.w = o.y; *(u32x4*)(hmid + (size_t)(u.pm * 256 + ai * 128 + wr * 64 + m * 16 + fr) * 2816 + c - 4) = o4; }
                }
            }
            asm volatile("" ::: "memory");
        }
    }
};
__device__ __forceinline__ void ffn_fix_phase(const int tid, const float* __restrict__ raw, bf16_t* __restrict__ hmid, const float* __restrict__ cw, const float* __restrict__ cb) {
    constexpr int NT = MTOK / 256, NITEM = NT * 2 * 352;
    for (int it = blockIdx.x * NTHR + tid; it < NITEM; it += gridDim.x * NTHR) {
        const int cgp = it % 352, te = it / 352, t = te >> 1, e = te & 1, c = cgp * 8, row = t * 256 + (e ? 255 : 0);
        int s0, s1; seq_bounds(row, s0, s1);
        const float* rc = raw + ((size_t)t * 4 + (e ? 3 : 0)) * 5632;
        const float* rpv = e ? raw + ((size_t)t * 4 + 2) * 5632 : (row > s0 ? raw + ((size_t)(t - 1) * 4 + 3) * 5632 : (const float*)nullptr);
        const float* rnx = e ? (row + 1 < s1 ? raw + ((size_t)(t + 1) * 4 + 0) * 5632 : (const float*)nullptr) : raw + ((size_t)t * 4 + 1) * 5632;
        float y[2][8];
#pragma unroll
        for (int g = 0; g < 2; ++g)
#pragma unroll
            for (int h = 0; h < 2; ++h) {
                const int cc = g * 2816 + c + 4 * h; const f32x4 zero = (f32x4){0.f, 0.f, 0.f, 0.f};
                const f32x4 xc = *(const f32x4*)(rc + cc), xp = rpv ? *(const f32x4*)(rpv + cc) : zero, xn = rnx ? *(const f32x4*)(rnx + cc) : zero;
                const f32x4 v = *(const f32x4*)(cb + cc) + *(const f32x4*)(cw + cc) * xp + *(const f32x4*)(cw + 5632 + cc) * xc + *(const f32x4*)(cw + 2 * 5632 + cc) * xn;
                y[g][4 * h] = v[0]; y[g][4 * h + 1] = v[1]; y[g][4 * h + 2] = v[2]; y[g][4 * h + 3] = v[3];
            }
        u32x4 o; o.x = cvt_pk_bf16(silu_f(y[1][0]) * y[0][0], silu_f(y[1][1]) * y[0][1]); o.y = cvt_pk_bf16(silu_f(y[1][2]) * y[0][2], silu_f(y[1][3]) * y[0][3]);
        o.z = cvt_pk_bf16(silu_f(y[1][4]) * y[0][4], silu_f(y[1][5]) * y[0][5]); o.w = cvt_pk_bf16(silu_f(y[1][6]) * y[0][6], silu_f(y[1][7]) * y[0][7]);
        *(u32x4*)(hmid + (size_t)row * 2816 + c) = o;
    }
}
template <class Epi>
__device__ __forceinline__ void run_gemm(const int tid, ldsp L, const bf16_t* A, const bf16_t* Bt, int M, int N, int K, const Epi& E) {
    pg8::Gemm g; g.A = A; g.Bt = Bt; g.M = M; g.N = N; g.K = K;
    pg8::StaticOrder S; S.init(M, N, (int)gridDim.x, (int)blockIdx.x);
#ifndef NO_GEMM
    pg8::gemm_phase<Epi, pg8::StaticOrder>(L, g, S, E, tid);
#endif
}

constexpr int P_QH = 0  , P_KH = 17408  , P_KT = 34816  , P_VT = 53248, P_LM0 = 71680  , P_LM1 = 89088, P_AT0 = 106496, P_AT1 = 115712, P_SC = 124928;
static_assert(P_SC + 2560 <= LDS_BYTES, "gdn local lds");
constexpr int S_QH = 0, S_KT = 17408, S_TW = 35840, S_AT = 45056, S_SC = 54272, S_BS = 55808  , S_WT = 2 * S_BS;
static_assert(S_WT + 17408 <= LDS_BYTES, "scan lds");
constexpr int GSC_STRIDE = 144;

__device__ __forceinline__ void gdn_local_phase(const int tid0, ldsp L, const Params& p, bf16_t* qkv, const bf16_t* __restrict__ halo, const float* __restrict__ gates,
                                                bf16_t* u_f, bf16_t* u_b, bf16_t* atb, float* gsc) {
    const float* convw = p.in[6];
    float pga = 0.f, pgb = 0.f;
    u32x4 xr[12];
#define P3_LOAD(itv) do { \
        int tidl; asm volatile("v_mov_b32 %0, %1" : "=v"(tidl) : "v"(tid0)); \
        if (tidl < 384) { \
            const int chunkl = (itv) >> 3, headl = (itv) & 7, t0l = chunkl * 64; int s0l, s1l; seq_bounds(t0l, s0l, s1l); \
            const int cgp = tidl % 48, rr = tidl / 48, tensor = cgp >> 4, c8 = (cgp & 15) * 8, col = tensor * 1024 + headl * 128 + c8; \
            _Pragma("unroll") for (int i = 0; i < 12; ++i) { const int lr = 8 * rr - 2 + i; const u32x4 zero = (u32x4){0u, 0u, 0u, 0u}; \
                if (lr < 0) xr[i] = (t0l > s0l) ? *(const u32x4*)(halo + ((size_t)chunkl * 4 + (lr + 2)) * 3072 + col) : zero; \
                else if (lr >= 64) xr[i] = (t0l + 64 < s1l) ? *(const u32x4*)(halo + ((size_t)(chunkl + 1) * 4 + (lr - 62)) * 3072 + col) : zero; \
                else xr[i] = *(const u32x4*)(qkv + (size_t)(t0l + lr) * 3072 + col); } } \
        else { const int dirl = (tidl >> 6) - 6, tl = ((itv) >> 3) * 64 + (tidl & 63), headl = (itv) & 7; \
            pga = gates[(size_t)tl * 32 + dirl * 8 + headl]; pgb = gates[(size_t)tl * 32 + (2 + dirl) * 8 + headl]; } } while (0)
    if ((int)blockIdx.x < (MTOK / 64) * 8) P3_LOAD((int)blockIdx.x);
    int cw_head = -1;
    for (int it = blockIdx.x; it < (MTOK / 64) * 8; it += gridDim.x) {
        int tid; asm volatile("v_mov_b32 %0, %1" : "=v"(tid) : "v"(tid0));
        const int wid = __builtin_amdgcn_readfirstlane(tid >> 6), lane = tid & 63, l15 = lane & 15, q4 = lane >> 4;
        const int chunk = it >> 3, head = it & 7, t0 = chunk * 64, slot = it;
        LAS float* CW = (LAS float*)(L + LDS_XCHG);
        if (head != cw_head) {
            for (int e = tid; e < 5 * 384; e += NTHR) { const int i = e / 384, cc = e % 384, tensor = cc >> 7, c = cc & 127; CW[e] = convw[i * 3072 + tensor * 1024 + head * 128 + c]; }
            cw_head = head;
            __syncthreads();
        }
        if (tid < 384) {
            const int cgp = tid % 48, rr = tid / 48, tensor = cgp >> 4, c8 = (cgp & 15) * 8;
#pragma unroll
            for (int hf = 0; hf < 2; ++hf) {
                float o[4][8];
#pragma unroll
                for (int r = 0; r < 4; ++r)
#pragma unroll
                    for (int c = 0; c < 8; ++c) o[r][c] = 0.f;
#pragma unroll
                for (int i = 0; i < 5; ++i) {
                    const f32x4 wa = *(LAS const f32x4*)(CW + i * 384 + tensor * 128 + c8), wb = *(LAS const f32x4*)(CW + i * 384 + tensor * 128 + c8 + 4);
#pragma unroll
                    for (int r = 0; r < 4; ++r) { const u32x4 x = xr[4 * hf + r + i];
                        o[r][0] += wa[0] * bf_lo(x.x); o[r][1] += wa[1] * bf_hi(x.x); o[r][2] += wa[2] * bf_lo(x.y); o[r][3] += wa[3] * bf_hi(x.y);
                        o[r][4] += wb[0] * bf_lo(x.z); o[r][5] += wb[1] * bf_hi(x.z); o[r][6] += wb[2] * bf_lo(x.w); o[r][7] += wb[3] * bf_hi(x.w); }
                }
#pragma unroll
                for (int r = 0; r < 4; ++r) {
                    float ss = 0.f;
#pragma unroll
                    for (int c = 0; c < 8; ++c) { o[r][c] = silu_f(o[r][c]); ss += o[r][c] * o[r][c]; }
                    ss += __shfl_xor(ss, 1); ss += __shfl_xor(ss, 2); ss += __shfl_xor(ss, 4); ss += __shfl_xor(ss, 8);
                    const float sc = tensor == 2 ? 1.f : rsqrtf(ss + 1e-6f) * (tensor == 0 ? 0.08838834764831845f : 1.f);
#pragma unroll
                    for (int c = 0; c < 8; ++c) o[r][c] *= sc;
                }
                if (tensor < 2) {
                    ldsp base = L + (tensor == 0 ? P_QH : P_KH) + (8 * rr + 4 * hf) * 272 + c8 * 2;
#pragma unroll
                    for (int r = 0; r < 4; ++r) { u32x4 v; v.x = cvt_pk_bf16(o[r][0], o[r][1]); v.y = cvt_pk_bf16(o[r][2], o[r][3]); v.z = cvt_pk_bf16(o[r][4], o[r][5]); v.w = cvt_pk_bf16(o[r][6], o[r][7]); *(LAS u32x4*)(base + r * 272) = v; }
                }
                if (tensor >= 1) {
                    ldsp base = L + (tensor == 1 ? P_KT : P_VT) + c8 * 144 + rr * 16 + hf * 8;
#pragma unroll
                    for (int c = 0; c < 8; ++c) { u32x2 v; v.x = cvt_pk_bf16(o[0][c], o[1][c]); v.y = cvt_pk_bf16(o[2][c], o[3][c]); *(LAS u32x2*)(base + c * 144) = v; }
                }
                FENCE();
            }
        } else {
            const int dir = wid - 6, t = t0 + lane;
            LAS float* SCgc = (LAS float*)(L + P_SC) + dir * 320;
            const float Aexp = expf(p.in[7][dir * 8 + head]), dtb = p.in[8][dir * 8 + head];
            const float a = pga, bb = pgb;
            const float x = a + dtb, sp = fmaxf(x, 0.f) + log1pf(expf(-fabsf(x))), g = -Aexp * sp, beta = 1.f / (1.f + expf(-bb));
            float pre = g;
#pragma unroll
            for (int o = 1; o < 64; o <<= 1) { const float y = __shfl_up(pre, o); if (lane >= o) pre += y; }
            const float tot = __shfl(pre, 63), gc = dir ? (tot - pre + g) : pre;
            const float egc = expf(gc), dec = expf(tot - gc), egl = expf(tot);
            SCgc[lane] = gc; SCgc[64 + lane] = beta; SCgc[128 + lane] = egc;
            float* gs = gsc + ((size_t)slot * 2 + dir) * GSC_STRIDE; gs[lane] = egc; gs[64 + lane] = dec; if (lane == 0) gs[128] = egl;
        }
        __syncthreads();
        if (it + (int)gridDim.x < (MTOK / 64) * 8) P3_LOAD(it + (int)gridDim.x);
#pragma unroll
        for (int j = 0; j < 2; ++j) { const int pi = tid + NTHR * j, row = pi >> 4, ch = pi & 15, dk = 2 * row + (ch >> 3);
            *(u32x4*)(qkv + (size_t)(t0 + row) * 3072 + head * 128 + ch * 8) = *(LAS const u32x4*)(L + P_QH + row * 272 + ch * 16);
            *(u32x4*)(qkv + (size_t)(t0 + row) * 3072 + 1024 + head * 128 + ch * 8) = *(LAS const u32x4*)(L + P_KT + dk * 144 + (ch & 7) * 16); }
        {
            const int mat = wid >> 2, rt = wid & 3;
            ldsp ab = L + (mat ? P_QH : P_KH) + (16 * rt + l15) * 272 + q4 * 16;
            bf16x8 af[4];
#pragma unroll
            for (int kk = 0; kk < 4; ++kk) af[kk] = *(LAS const bf16x8*)(ab + kk * 64);
            LAS const float* SC0 = (LAS const float*)(L + P_SC); LAS const float* SC1 = SC0 + 320;
#pragma unroll
            for (int ct = 0; ct < 4; ++ct) {
                ldsp bb = L + P_KH + (16 * ct + l15) * 272 + q4 * 16;
                f32x4 acc = (f32x4){0.f, 0.f, 0.f, 0.f};
#pragma unroll
                for (int kk = 0; kk < 4; ++kk) acc = MFMA16(af[kk], *(LAS const bf16x8*)(bb + kk * 64), acc);
                const int s = 16 * ct + l15; const float gs0 = SC0[s], gs1 = SC1[s];
#pragma unroll
                for (int j = 0; j < 4; ++j) {
                    const int c = 16 * rt + 4 * q4 + j; const float e0 = __expf(SC0[c] - gs0), e1 = __expf(SC1[c] - gs1);
                    if (mat == 0) {
                        ((LAS float*)(L + P_LM0))[c * 68 + s] = (s < c) ? acc[j] * SC0[64 + c] * e0 : 0.f;
                        ((LAS float*)(L + P_LM1))[(63 - c) * 68 + (63 - s)] = (s > c) ? acc[j] * SC1[64 + c] * e1 : 0.f;
                    } else {
                        *(LAS unsigned short*)(L + P_AT0 + c * 144 + s * 2) = f2bf((s <= c) ? acc[j] * e0 : 0.f);
                        *(LAS unsigned short*)(L + P_AT1 + c * 144 + s * 2) = f2bf((s >= c) ? acc[j] * e1 : 0.f);
                    }
                }
            }
        }
        __syncthreads();
        {
            if (tid < 128) {
                const int d = tid >> 6, t6 = tid & 63, b = t6 >> 4, j = t6 & 15;
                LAS const float* LM = (LAS const float*)(L + (d ? P_LM1 : P_LM0)); LAS float* TM = (LAS float*)(L + (d ? P_QH : P_KH)); float x[16];
#pragma unroll
                for (int i = 0; i < 16; ++i) { float a = (i == j) ? 1.f : 0.f;
#pragma unroll
                    for (int s = 0; s < i; ++s) a -= LM[(16 * b + i) * 68 + 16 * b + s] * x[s];
                    x[i] = a; TM[(16 * b + i) * 68 + 16 * b + j] = a; if ((i & 3) == 3) FENCE(); }
            } else {
                for (int e = tid - 128; e < 3072; e += NTHR - 128) { const int d = e >= 1536, e1 = d ? e - 1536 : e, blk = e1 >> 8, w = e1 & 255, i = w >> 4, j = w & 15;
                    const int bi = blk < 3 ? 0 : (blk < 5 ? 1 : 2), bj = blk < 3 ? blk + 1 : (blk < 5 ? blk - 1 : 3);
                    ((LAS float*)(L + (d ? P_QH : P_KH)))[(16 * bi + i) * 68 + 16 * bj + j] = 0.f; }
            }
            __syncthreads();
            if (tid < 256) {
                const int d = tid >> 7, t7 = tid & 127, hb = t7 >> 6, r0 = 32 * hb, i = (t7 & 63) >> 2, j4 = (t7 & 3) * 4; f32x4 y = (f32x4){0.f, 0.f, 0.f, 0.f};
                LAS const float* LM = (LAS const float*)(L + (d ? P_LM1 : P_LM0)); LAS const float* TM = (LAS const float*)(L + (d ? P_QH : P_KH)); LAS float* YS = (LAS float*)(L + P_KT + d * 4608);
#pragma unroll
                for (int k = 0; k < 16; k += 4) { const f32x4 a = *(LAS const f32x4*)(LM + (r0 + 16 + i) * 68 + r0 + k);
#pragma unroll
                    for (int kk = 0; kk < 4; ++kk) y += a[kk] * *(LAS const f32x4*)(TM + (r0 + k + kk) * 68 + r0 + j4); }
                *(LAS f32x4*)(YS + (hb * 16 + i) * 36 + j4) = y;
            }
            __syncthreads();
            if (tid < 256) {
                const int d = tid >> 7, t7 = tid & 127, hb = t7 >> 6, r0 = 32 * hb, i = (t7 & 63) >> 2, j4 = (t7 & 3) * 4; f32x4 y = (f32x4){0.f, 0.f, 0.f, 0.f};
                LAS float* TM = (LAS float*)(L + (d ? P_QH : P_KH)); LAS const float* YS = (LAS const float*)(L + P_KT + d * 4608);
#pragma unroll
                for (int k = 0; k < 16; k += 4) { const f32x4 a = *(LAS const f32x4*)(TM + (r0 + 16 + i) * 68 + r0 + 16 + k);
#pragma unroll
                    for (int kk = 0; kk < 4; ++kk) y -= a[kk] * *(LAS const f32x4*)(YS + (hb * 16 + k + kk) * 36 + j4); }
                *(LAS f32x4*)(TM + (r0 + 16 + i) * 68 + r0 + j4) = y;
            }
            __syncthreads();
            {
                const int d = tid >> 8, t8 = tid & 255, i = t8 >> 3, j4 = (t8 & 7) * 4; f32x4 y = (f32x4){0.f, 0.f, 0.f, 0.f};
                LAS const float* LM = (LAS const float*)(L + (d ? P_LM1 : P_LM0)); LAS const float* TM = (LAS const float*)(L + (d ? P_QH : P_KH)); LAS float* YS = (LAS float*)(L + P_KT + d * 4608);
#pragma unroll
                for (int k = 0; k < 32; k += 4) { const f32x4 a = *(LAS const f32x4*)(LM + (32 + i) * 68 + k);
#pragma unroll
                    for (int kk = 0; kk < 4; ++kk) y += a[kk] * *(LAS const f32x4*)(TM + (k + kk) * 68 + j4); }
                *(LAS f32x4*)(YS + i * 36 + j4) = y;
            }
            __syncthreads();
            {
                const int d = tid >> 8, t8 = tid & 255, i = t8 >> 3, j4 = (t8 & 7) * 4; f32x4 y = (f32x4){0.f, 0.f, 0.f, 0.f};
                LAS float* TM = (LAS float*)(L + (d ? P_QH : P_KH)); LAS const float* YS = (LAS const float*)(L + P_KT + d * 4608);
#pragma unroll
                for (int k = 0; k < 32; k += 4) { const f32x4 a = *(LAS const f32x4*)(TM + (32 + i) * 68 + 32 + k);
#pragma unroll
                    for (int kk = 0; kk < 4; ++kk) y -= a[kk] * *(LAS const f32x4*)(YS + (k + kk) * 36 + j4); }
                *(LAS f32x4*)(TM + (32 + i) * 68 + j4) = y;
            }
            __syncthreads();
#pragma unroll
            for (int dir = 0; dir < 2; ++dir) {
                LAS const float* TM = (LAS const float*)(L + (dir ? P_QH : P_KH)); LAS const float* SCd = (LAS const float*)(L + P_SC) + dir * 320;
                const int c = tid >> 3, s8 = (tid & 7) * 8, fc = dir ? 63 - c : c; float tb[8], tw[8];
#pragma unroll
                for (int e = 0; e < 8; ++e) { const int s = s8 + e, fs = dir ? 63 - s : s; const float tv = TM[fc * 68 + fs]; tb[e] = tv * SCd[64 + s]; tw[e] = tb[e] * SCd[128 + s]; }
                u32x4 v; v.x = cvt_pk_bf16(tb[0], tb[1]); v.y = cvt_pk_bf16(tb[2], tb[3]); v.z = cvt_pk_bf16(tb[4], tb[5]); v.w = cvt_pk_bf16(tb[6], tb[7]);
                u32x4 w2; w2.x = cvt_pk_bf16(tw[0], tw[1]); w2.y = cvt_pk_bf16(tw[2], tw[3]); w2.z = cvt_pk_bf16(tw[4], tw[5]); w2.w = cvt_pk_bf16(tw[6], tw[7]);
                *(u32x4*)(qkv + (size_t)(t0 + 32 * dir + (c >> 1)) * 3072 + 2048 + head * 128 + (c & 1) * 64 + s8) = w2;
                *(u32x4*)(atb + ((size_t)slot * 2 + dir) * 4096 + c * 64 + s8) = *(LAS const u32x4*)(L + (dir ? P_AT1 : P_AT0) + c * 144 + s8 * 2);
                *(LAS u32x4*)(L + P_LM0 + dir * 9216 + c * 144 + s8 * 2) = v;
            }
            __syncthreads();
#pragma unroll
            for (int dir = 0; dir < 2; ++dir) {
                const int dv0 = 16 * wid; f32x4 vn[4];
#pragma unroll
                for (int ct = 0; ct < 4; ++ct) vn[ct] = (f32x4){0.f, 0.f, 0.f, 0.f};
#pragma unroll
                for (int kk = 0; kk < 2; ++kk) { const bf16x8 bv = *(LAS const bf16x8*)(L + P_VT + (dv0 + l15) * 144 + kk * 64 + q4 * 16);
#pragma unroll
                    for (int ct = 0; ct < 4; ++ct) vn[ct] = MFMA16(*(LAS const bf16x8*)(L + P_LM0 + dir * 9216 + (16 * ct + l15) * 144 + kk * 64 + q4 * 16), bv, vn[ct]); }
                bf16_t* ub = (dir ? u_b : u_f) + ((size_t)slot * 128 + dv0 + l15) * 64 + 16 * q4;
#pragma unroll
                for (int h = 0; h < 2; ++h) { u32x4 v; v.x = cvt_pk_bf16(vn[2 * h][0], vn[2 * h][1]); v.y = cvt_pk_bf16(vn[2 * h][2], vn[2 * h][3]); v.z = cvt_pk_bf16(vn[2 * h + 1][0], vn[2 * h + 1][1]); v.w = cvt_pk_bf16(vn[2 * h + 1][2], vn[2 * h + 1][3]); *(u32x4*)(ub + 8 * h) = v; }
            }
            __syncthreads();
        }
    }
}

#undef P3_LOAD
__device__ __forceinline__ void gdn_scan_item(const int tid0, ldsp L, int gi, const int dvbase, const int nact, const bf16_t* __restrict__ qkv, bf16_t* u_f, bf16_t* u_b, const bf16_t* __restrict__ atb, const float* __restrict__ gsc, bf16_t* op_f, bf16_t* op_b) {
    int head, dir, tbase, nsteps;
    if (gi < 16) { head = gi & 7; dir = gi >> 3; tbase = 0; nsteps = TPROMPT / 64; }
    else { const int j = gi - 16; head = j & 7; dir = (j >> 3) & 1; tbase = TPROMPT + (j >> 4) * TSAMP; nsteps = TSAMP / 64; }
    bf16_t* ubuf = dir ? u_b : u_f; bf16_t* opbuf = dir ? op_b : op_f;
    f32x4 S[8];
#pragma unroll
    for (int i = 0; i < 8; ++i) S[i] = (f32x4){0.f, 0.f, 0.f, 0.f};
    u32x4 pq[2], pk[2], ptw, pat; u32x2 pu[4]; float psc = 0.f;
#pragma unroll
    for (int ct = 0; ct < 4; ++ct) pu[ct] = (u32x2){0u, 0u};
#define GDN_PREFETCH(stepv) do { \
        int tidp; asm volatile("v_mov_b32 %0, %1" : "=v"(tidp) : "v"(tid0)); \
        const int chunkp = dir ? nsteps - 1 - (stepv) : (stepv), t0p = tbase + 64 * chunkp, slotp = (t0p >> 6) * 8 + head, lanep = tidp & 63, widp = __builtin_amdgcn_readfirstlane(tidp >> 6); \
        const bf16_t* up = ubuf + ((size_t)slotp * 128 + dvbase + 16 * widp + (lanep & 15)) * 64 + 16 * (lanep >> 4); \
        if (widp < nact) { const u32x4 p01 = *(const u32x4*)up, p23 = *(const u32x4*)(up + 8); pu[0] = (u32x2){p01.x, p01.y}; pu[1] = (u32x2){p01.z, p01.w}; pu[2] = (u32x2){p23.x, p23.y}; pu[3] = (u32x2){p23.z, p23.w}; } \
        _Pragma("unroll") for (int j = 0; j < 2; ++j) { const int pi = tidp + NTHR * j, row = pi >> 4, ch = pi & 15; \
            pq[j] = *(const u32x4*)(qkv + (size_t)(t0p + row) * 3072 + head * 128 + ch * 8); pk[j] = *(const u32x4*)(qkv + (size_t)(t0p + row) * 3072 + 1024 + head * 128 + ch * 8); } \
        ptw = *(const u32x4*)(qkv + (size_t)(t0p + 32 * dir + (tidp >> 4)) * 3072 + 2048 + head * 128 + (tidp & 15) * 8); \
        pat = *(const u32x4*)(atb + ((size_t)slotp * 2 + dir) * 4096 + tidp * 8); \
        psc = (tidp < 129) ? gsc[((size_t)slotp * 2 + dir) * GSC_STRIDE + tidp] : 0.f; } while (0)
#define GDN_STAGE(bo) do { \
        int tids; asm volatile("v_mov_b32 %0, %1" : "=v"(tids) : "v"(tid0)); \
        _Pragma("unroll") for (int j = 0; j < 2; ++j) { const int pi = tids + NTHR * j, row = pi >> 4, ch = pi & 15, dk = 2 * row + (ch >> 3); \
            *(LAS u32x4*)(L + (bo) + S_QH + row * 272 + ch * 16) = pq[j]; *(LAS u32x4*)(L + (bo) + S_KT + dk * 144 + (ch & 7) * 16) = pk[j]; } \
        { const int c = 2 * (tids >> 4) + ((tids & 15) >> 3); *(LAS u32x4*)(L + (bo) + S_TW + c * 144 + (tids & 7) * 16) = ptw; } \
        *(LAS u32x4*)(L + (bo) + S_AT + (tids >> 3) * 144 + (tids & 7) * 16) = pat; \
        if (tids < 129) ((LAS float*)(L + (bo) + S_SC))[tids] = psc; } while (0)
    u32x2 uc[4], un[4];
    GDN_PREFETCH(0);
    GDN_STAGE(0);
#pragma unroll
    for (int ct = 0; ct < 4; ++ct) { uc[ct] = pu[ct]; un[ct] = pu[ct]; }
    if (nsteps > 1) GDN_PREFETCH(1);
    __syncthreads();
    for (int step = 0; step < nsteps; ++step) {
        int tid; asm volatile("v_mov_b32 %0, %1" : "=v"(tid) : "v"(tid0));
        const int wid = __builtin_amdgcn_readfirstlane(tid >> 6), lane = tid & 63, l15 = lane & 15, q4 = lane >> 4;
        const int chunk = dir ? nsteps - 1 - step : step, t0 = tbase + 64 * chunk, slot = (t0 >> 6) * 8 + head;
        const int bo = (step & 1) * S_BS, bn = S_BS - bo;
        {
            ldsp ab = L + bo + S_KT + (16 * wid + l15) * 144 + q4 * 16;
            const bf16x8 a0 = *(LAS const bf16x8*)ab, a1 = *(LAS const bf16x8*)(ab + 64);
#pragma unroll
            for (int ct = 0; ct < 4; ++ct) {
                ldsp bb = L + bo + S_TW + (16 * ct + l15) * 144 + q4 * 16;
                f32x4 acc = (f32x4){0.f, 0.f, 0.f, 0.f};
                acc = MFMA16(a0, *(LAS const bf16x8*)bb, acc); acc = MFMA16(a1, *(LAS const bf16x8*)(bb + 64), acc);
                u32x2 v; v.x = cvt_pk_bf16(-acc[0], -acc[1]); v.y = cvt_pk_bf16(-acc[2], -acc[3]);
                *(LAS u32x2*)(L + S_WT + (16 * ct + l15) * 272 + (16 * wid + 4 * q4) * 2) = v;
            }
        }
        __syncthreads();
        if (step + 1 < nsteps) {
            GDN_STAGE(bn);
#pragma unroll
            for (int ct = 0; ct < 4; ++ct) un[ct] = pu[ct];
            if (step + 2 < nsteps) GDN_PREFETCH(step + 2);
        }
        if (wid < nact) {
            const int dv0 = dvbase + 16 * wid;
            LAS const float* SCegc = (LAS const float*)(L + bo + S_SC); LAS const float* SCdec = SCegc + 64;
            f32x4 vn[4], R[4];
#pragma unroll
            for (int ct = 0; ct < 4; ++ct) { vn[ct][0] = bf_lo(uc[ct].x); vn[ct][1] = bf_hi(uc[ct].x); vn[ct][2] = bf_lo(uc[ct].y); vn[ct][3] = bf_hi(uc[ct].y); R[ct] = (f32x4){0.f, 0.f, 0.f, 0.f}; }
#pragma unroll
            for (int kk = 0; kk < 4; ++kk) {
                const bf16x8 sb = pack8(S[2 * kk], S[2 * kk + 1]);
#pragma unroll
                for (int ct = 0; ct < 4; ++ct) { const int off = (16 * ct + l15) * 272 + (32 * kk + 4 * q4) * 2;
                    vn[ct] = MFMA16(lds_read2(L + S_WT + off), sb, vn[ct]); R[ct] = MFMA16(lds_read2(L + bo + S_QH + off), sb, R[ct]); }
            }
#pragma unroll
            for (int ct = 0; ct < 4; ++ct) R[ct] *= *(LAS const f32x4*)(SCegc + 16 * ct + 4 * q4);
            bf16x8 Vb[2], Vd[2];
#pragma unroll
            for (int kk = 0; kk < 2; ++kk) { Vb[kk] = pack8(vn[2 * kk], vn[2 * kk + 1]);
                Vd[kk] = pack8(vn[2 * kk] * *(LAS const f32x4*)(SCdec + 32 * kk + 4 * q4), vn[2 * kk + 1] * *(LAS const f32x4*)(SCdec + 32 * kk + 16 + 4 * q4)); }
            FENCE();
#pragma unroll
            for (int kk = 0; kk < 2; ++kk)
#pragma unroll
                for (int ct = 0; ct < 4; ++ct) R[ct] = MFMA16(lds_read2(L + bo + S_AT + (16 * ct + l15) * 144 + (32 * kk + 4 * q4) * 2), Vb[kk], R[ct]);
            if (opbuf) {
                bf16_t* ob = opbuf + ((size_t)slot * 128 + dv0 + l15) * 64 + 16 * q4;
#pragma unroll
                for (int h = 0; h < 2; ++h) { u32x4 v; v.x = cvt_pk_bf16(R[2 * h][0], R[2 * h][1]); v.y = cvt_pk_bf16(R[2 * h][2], R[2 * h][3]); v.z = cvt_pk_bf16(R[2 * h + 1][0], R[2 * h + 1][1]); v.w = cvt_pk_bf16(R[2 * h + 1][2], R[2 * h + 1][3]); *(u32x4*)(ob + 8 * h) = v; }
            } else {
                bf16_t* ob = ubuf + (size_t)slot * 8192 + dv0 + l15;
#pragma unroll
                for (int ct = 0; ct < 4; ++ct)
#pragma unroll
                    for (int j = 0; j < 4; ++j) ob[(16 * ct + 4 * q4 + j) * 128] = f2bf(R[ct][j]);
            }
            FENCE();
            const float egl = SCegc[128];
#pragma unroll
            for (int dkt = 0; dkt < 8; ++dkt) { S[dkt] *= egl;
#pragma unroll
                for (int kk = 0; kk < 2; ++kk) S[dkt] = MFMA16(lds_read2(L + bo + S_KT + (16 * dkt + l15) * 144 + (32 * kk + 4 * q4) * 2), Vd[kk], S[dkt]);
                if (dkt == 3) FENCE(); }
        }
#pragma unroll
        for (int ct = 0; ct < 4; ++ct) uc[ct] = un[ct];
        __syncthreads();
    }
#undef GDN_STAGE
#undef GDN_PREFETCH
}
constexpr int PSPLIT = 4;
__device__ __forceinline__ void gdn_scan_phase(const int tid, ldsp L, const bf16_t* qkv, bf16_t* u_f, bf16_t* u_b, const bf16_t* atb, const float* gsc, bf16_t* op_f, bf16_t* op_b) {
    const int b = blockIdx.x, G = gridDim.x;
    constexpr int NP = 16 * PSPLIT, NIT = NP + 256;
    for (int k = 0; k < 4; ++k) {
        int it;
        if (k == 0) it = b; else { if (b < NP || G <= NP) break; it = G + (k - 1) * (G - NP) + (b - NP); }
        if (it >= NIT) break;
        int gi, dvbase, nact; const bool prompt = it < NP;
        if (prompt) { gi = it / PSPLIT; dvbase = (it % PSPLIT) * (128 / PSPLIT); nact = 8 / PSPLIT; } else { gi = 16 + (it - NP); dvbase = 0; nact = 8; }
        __syncthreads();
        gdn_scan_item(tid, L, gi, dvbase, nact, qkv, u_f, u_b, atb, gsc, prompt ? op_f : (bf16_t*)nullptr, prompt ? op_b : (bf16_t*)nullptr);
    }
}

__device__ __forceinline__ void gdn_combine_phase(const int tid0, ldsp L, const Params& p, const bf16_t* o_f, const bf16_t* o_b, const bf16_t* z, bf16_t* dst, const bf16_t* __restrict__ op_f, const bf16_t* __restrict__ op_b) {
    const float* nw = p.in[9];
    LAS float* T = (LAS float*)L;
    for (int it = blockIdx.x; it < (TPROMPT / 64) * 8; it += gridDim.x) {
        int tid; asm volatile("v_mov_b32 %0, %1" : "=v"(tid) : "v"(tid0));
        const int chunk = it >> 3, head = it & 7, t0 = chunk * 64;
        __syncthreads();
#pragma unroll
        for (int j = 0; j < 2; ++j) { const int pi = tid + NTHR * j, dv = pi >> 3, c8 = (pi & 7) * 8; const size_t off = ((size_t)it * 128 + dv) * 64 + c8;
            const u32x4 a = *(const u32x4*)(op_f + off), b = *(const u32x4*)(op_b + off);
            const int cA = 16 * ((c8 >> 2) & 3) + 4 * (c8 >> 4), cB = cA + 16;
            T[(cA + 0) * 132 + dv] = bf_lo(a.x) + bf_lo(b.x); T[(cA + 1) * 132 + dv] = bf_hi(a.x) + bf_hi(b.x); T[(cA + 2) * 132 + dv] = bf_lo(a.y) + bf_lo(b.y); T[(cA + 3) * 132 + dv] = bf_hi(a.y) + bf_hi(b.y);
            T[(cB + 0) * 132 + dv] = bf_lo(a.z) + bf_lo(b.z); T[(cB + 1) * 132 + dv] = bf_hi(a.z) + bf_hi(b.z); T[(cB + 2) * 132 + dv] = bf_lo(a.w) + bf_lo(b.w); T[(cB + 3) * 132 + dv] = bf_hi(a.w) + bf_hi(b.w); }
        __syncthreads();
        const int c = tid >> 3, d16 = (tid & 7) * 16;
        float o[16]; float ss = 0.f;
#pragma unroll
        for (int e4 = 0; e4 < 4; ++e4) { const f32x4 v = *(LAS const f32x4*)(T + c * 132 + d16 + 4 * e4); o[4 * e4] = v[0]; o[4 * e4 + 1] = v[1]; o[4 * e4 + 2] = v[2]; o[4 * e4 + 3] = v[3]; ss += v[0] * v[0] + v[1] * v[1] + v[2] * v[2] + v[3] * v[3]; }
        ss += __shfl_xor(ss, 1); ss += __shfl_xor(ss, 2); ss += __shfl_xor(ss, 4);
        const float r = rsqrtf(ss * (1.f / 128.f) + 1e-6f);
        const size_t zoff = (size_t)(t0 + c) * 1024 + head * 128 + d16;
        const u32x4 z0 = *(const u32x4*)(z + zoff), z1 = *(const u32x4*)(z + zoff + 8);
        const unsigned zz[8] = {z0.x, z0.y, z0.z, z0.w, z1.x, z1.y, z1.z, z1.w};
        unsigned ov[8];
#pragma unroll
        for (int e2 = 0; e2 < 8; ++e2) { const float y0 = o[2 * e2] * r * nw[d16 + 2 * e2] * silu_f(bf_lo(zz[e2])), y1 = o[2 * e2 + 1] * r * nw[d16 + 2 * e2 + 1] * silu_f(bf_hi(zz[e2])); ov[e2] = cvt_pk_bf16(y0, y1); }
        u32x4 v0, v1; v0.x = ov[0]; v0.y = ov[1]; v0.z = ov[2]; v0.w = ov[3]; v1.x = ov[4]; v1.y = ov[5]; v1.z = ov[6]; v1.w = ov[7];
        *(u32x4*)(dst + zoff) = v0; *(u32x4*)(dst + zoff + 8) = v1;
    }
    int tid; asm volatile("v_mov_b32 %0, %1" : "=v"(tid) : "v"(tid0));
    const int lane = tid & 63, wid = tid >> 6, d8 = (lane & 15) * 8;
    const f32x4 w0 = *(const f32x4*)(nw + d8), w1 = *(const f32x4*)(nw + d8 + 4);
    const int SW = gridDim.x * 8;
    for (int it0 = TPROMPT * 2 + blockIdx.x * 8 + wid; it0 < MTOK * 2; it0 += 2 * SW) {
        u32x4 zz2[2], a2[2], b2[2];
#pragma unroll
        for (int u = 0; u < 2; ++u) { const int it = it0 + u * SW < MTOK * 2 ? it0 + u * SW : it0; const int tk = it >> 1, hd = (it & 1) * 4 + (lane >> 4);
            const size_t off = (size_t)tk * 1024 + (it & 1) * 512 + lane * 8, ooff = ((size_t)((tk >> 6) * 8 + hd) * 64 + (tk & 63)) * 128 + d8;
            zz2[u] = *(const u32x4*)(z + off); a2[u] = *(const u32x4*)(o_f + ooff); b2[u] = *(const u32x4*)(o_b + ooff); }
#pragma unroll
        for (int u = 0; u < 2; ++u) { const int it = it0 + u * SW; if (it >= MTOK * 2) break;
            const int tk = it >> 1; const size_t off = (size_t)tk * 1024 + (it & 1) * 512 + lane * 8;
            const u32x4 zz = zz2[u], a = a2[u], b = b2[u];
            float o[8];
            o[0] = bf_lo(a.x) + bf_lo(b.x); o[1] = bf_hi(a.x) + bf_hi(b.x); o[2] = bf_lo(a.y) + bf_lo(b.y); o[3] = bf_hi(a.y) + bf_hi(b.y); o[4] = bf_lo(a.z) + bf_lo(b.z); o[5] = bf_hi(a.z) + bf_hi(b.z); o[6] = bf_lo(a.w) + bf_lo(b.w); o[7] = bf_hi(a.w) + bf_hi(b.w);
            const float zf[8] = {bf_lo(zz.x), bf_hi(zz.x), bf_lo(zz.y), bf_hi(zz.y), bf_lo(zz.z), bf_hi(zz.z), bf_lo(zz.w), bf_hi(zz.w)};
            float ss = 0.f;
#pragma unroll
            for (int e = 0; e < 8; ++e) ss += o[e] * o[e];
            ss += __shfl_xor(ss, 1); ss += __shfl_xor(ss, 2); ss += __shfl_xor(ss, 4); ss += __shfl_xor(ss, 8);
            const float r = rsqrtf(ss * (1.f / 128.f) + 1e-6f);
            float y[8];
#pragma unroll
            for (int e = 0; e < 8; ++e) y[e] = o[e] * r * (e < 4 ? w0[e] : w1[e - 4]) * silu_f(zf[e]);
            u32x4 v; v.x = cvt_pk_bf16(y[0], y[1]); v.y = cvt_pk_bf16(y[2], y[3]); v.z = cvt_pk_bf16(y[4], y[5]); v.w = cvt_pk_bf16(y[6], y[7]);
            *(u32x4*)(dst + off) = v; }
    }
}

__device__ __forceinline__ void ffn_act_phase(const int tid, const bf16_t* __restrict__ up, bf16_t* __restrict__ hmid, const float* __restrict__ cw, const float* __restrict__ cb, int slab_row0, int slab_rows) {
    constexpr int RUN = 8, NCG = 352; const int NITEM = NCG * (slab_rows / RUN);
    for (int it = blockIdx.x * NTHR + tid; it < NITEM; it += gridDim.x * NTHR) {
        const int cgp = it % NCG, run = it / NCG, c = cgp * 8, lr0 = run * RUN;
        int s0, s1; seq_bounds(slab_row0 + lr0, s0, s1); s0 -= slab_row0; s1 -= slab_row0;
        const u32x4 zero = (u32x4){0u, 0u, 0u, 0u};
        u32x4 xv[RUN + 2], xg[RUN + 2];
#pragma unroll
        for (int i = 0; i < RUN + 2; ++i) { const int lr = lr0 - 1 + i; const bool ok = (i > 0 || lr >= s0) && (i < RUN + 1 || lr < s1);
            xv[i] = ok ? *(const u32x4*)(up + (size_t)lr * 5632 + c) : zero; xg[i] = ok ? *(const u32x4*)(up + (size_t)lr * 5632 + 2816 + c) : zero; }
        f32x4 wv[3][2], wg[3][2], bv[2], bg[2];
#pragma unroll
        for (int i = 0; i < 3; ++i)
#pragma unroll
            for (int h = 0; h < 2; ++h) { wv[i][h] = *(const f32x4*)(cw + i * 5632 + c + 4 * h); wg[i][h] = *(const f32x4*)(cw + i * 5632 + 2816 + c + 4 * h); }
#pragma unroll
        for (int h = 0; h < 2; ++h) { bv[h] = *(const f32x4*)(cb + c + 4 * h); bg[h] = *(const f32x4*)(cb + 2816 + c + 4 * h); }
#pragma unroll
        for (int r = 0; r < RUN; ++r) {
            float y[8];
#pragma unroll
            for (int e2 = 0; e2 < 4; ++e2) {
                const unsigned a0 = xv[r][e2], a1 = xv[r + 1][e2], a2 = xv[r + 2][e2], g0 = xg[r][e2], g1 = xg[r + 1][e2], g2 = xg[r + 2][e2];
                const int h = e2 >> 1, k = (e2 & 1) * 2;
                const float v0 = bv[h][k] + wv[0][h][k] * bf_lo(a0) + wv[1][h][k] * bf_lo(a1) + wv[2][h][k] * bf_lo(a2), v1 = bv[h][k + 1] + wv[0][h][k + 1] * bf_hi(a0) + wv[1][h][k + 1] * bf_hi(a1) + wv[2][h][k + 1] * bf_hi(a2);
                const float q0 = bg[h][k] + wg[0][h][k] * bf_lo(g0) + wg[1][h][k] * bf_lo(g1) + wg[2][h][k] * bf_lo(g2), q1 = bg[h][k + 1] + wg[0][h][k + 1] * bf_hi(g0) + wg[1][h][k + 1] * bf_hi(g1) + wg[2][h][k + 1] * bf_hi(g2);
                y[2 * e2] = silu_f(q0) * v0; y[2 * e2 + 1] = silu_f(q1) * v1;
            }
            u32x4 v; v.x = cvt_pk_bf16(y[0], y[1]); v.y = cvt_pk_bf16(y[2], y[3]); v.z = cvt_pk_bf16(y[4], y[5]); v.w = cvt_pk_bf16(y[6], y[7]);
            *(u32x4*)(hmid + (size_t)(lr0 + r) * 2816 + c) = v;
        }
    }
}

__device__ __forceinline__ int t5_bucket_abs(int n) { return n < 8 ? n : (n < 15 ? 8 : n < 27 ? 9 : n < 50 ? 10 : n < 91 ? 11 : n < 166 ? 12 : n < 305 ? 13 : n < 559 ? 14 : 15); }
constexpr int A_VT = 0, A_VTP = 392  , A_BIAS = 64 * A_VTP * 2;
__device__ __forceinline__ void attn_phase(const int tid0, ldsp L, const Params& p, const bf16_t* __restrict__ qkv, bf16_t* __restrict__ ao, float* __restrict__ lse) {
    LAS float* BT = (LAS float*)(L + A_BIAS);
    const float* rel_bias = p.in[13];
    for (int it = blockIdx.x; it < (MTOK / 256) * 12; it += gridDim.x) {
        int tid; asm volatile("v_mov_b32 %0, %1" : "=v"(tid) : "v"(tid0));
        const int wid = __builtin_amdgcn_readfirstlane(tid >> 6), lane = tid & 63, n32 = lane & 31, h2 = lane >> 5;
        const int tb = it / 12, head = it % 12, g = head >> 2, dsh = 2 * g, d = 1 << dsh;
        int s0, Ts, lb;
        if (tb < 64) { s0 = 0; Ts = TPROMPT; lb = tb; } else { s0 = TPROMPT + ((tb - 64) >> 4) * TSAMP; Ts = TSAMP; lb = (tb - 64) & 15; }
        const int Lq = Ts >> dsh, r = lb & (d - 1), st = lb >> dsh, p0 = 256 * st;
        __syncthreads();
        if (tid < 129) { const int rel = (tid - 64) * d, n = rel < 0 ? -rel : rel; BT[tid] = rel_bias[((rel > 0 ? 16 : 0) + t5_bucket_abs(n)) * 12 + head]; }
        u32x4 vv[6];
#pragma unroll
        for (int i = 0; i < 6; ++i) {
            const int idx = tid + NTHR * i, key = idx >> 3, ch = idx & 7; int pk = p0 - 64 + key; pk = pk < 0 ? 0 : (pk >= Lq ? Lq - 1 : pk);
            vv[i] = *(const u32x4*)(qkv + (size_t)(s0 + (pk << dsh) + r) * 2304 + 1536 + head * 64 + ch * 8);
        }
        const int qp = p0 + 32 * wid + n32; const size_t qtok = (size_t)(s0 + (qp << dsh) + r);
        bf16x8 qf[4];
#pragma unroll
        for (int kk = 0; kk < 4; ++kk) qf[kk] = *(const bf16x8*)(qkv + qtok * 2304 + head * 64 + 16 * kk + 8 * h2);
        f32x16 sc[5];
#pragma unroll
        for (int jt = 0; jt < 5; ++jt) {
            int kp = p0 + 32 * wid - 64 + 32 * jt + n32; kp = kp < 0 ? 0 : (kp >= Lq ? Lq - 1 : kp);
            const bf16_t* kr = qkv + (size_t)(s0 + (kp << dsh) + r) * 2304 + 768 + head * 64 + 8 * h2;
            f32x16 a;
#pragma unroll
            for (int e = 0; e < 16; ++e) a[e] = 0.f;
#pragma unroll
            for (int kk = 0; kk < 4; ++kk) a = MFMA32(*(const bf16x8*)(kr + 16 * kk), qf[kk], a);
            sc[jt] = a;
        }
#pragma unroll
        for (int i = 0; i < 6; ++i) {
            const int idx = tid + NTHR * i, key = idx >> 3, ch = idx & 7; const u32x4 v = vv[i];
            LAS unsigned short* vt = (LAS unsigned short*)(L + A_VT) + (ch * 8) * A_VTP + key;
            vt[0] = (unsigned short)(v.x & 0xffffu); vt[A_VTP] = (unsigned short)(v.x >> 16); vt[2 * A_VTP] = (unsigned short)(v.y & 0xffffu); vt[3 * A_VTP] = (unsigned short)(v.y >> 16);
            vt[4 * A_VTP] = (unsigned short)(v.z & 0xffffu); vt[5 * A_VTP] = (unsigned short)(v.z >> 16); vt[6 * A_VTP] = (unsigned short)(v.w & 0xffffu); vt[7 * A_VTP] = (unsigned short)(v.w >> 16);
        }
        __syncthreads();
        float mx = -3.0e38f, sum = 0.f;
        const bool interior = (p0 + 32 * wid - 64 >= 0) && (p0 + 32 * wid + 95 < Lq);
        if (interior) {
            const int dl = 4 * h2 - n32;
#pragma unroll
            for (int jt = 0; jt < 5; ++jt)
#pragma unroll
                for (int e = 0; e < 16; ++e) {
                    const int rel = 32 * jt - 64 + (e & 3) + 8 * (e >> 2) + dl;
                    float lg = sc[jt][e] * 0.125f + BT[(jt == 0 ? (rel < -64 ? -64 : rel) : (jt == 4 ? (rel > 64 ? 64 : rel) : rel)) + 64];
                    if (jt == 0) lg = rel >= -64 ? lg : -1.0e30f;
                    if (jt == 4) lg = rel <= 64 ? lg : -1.0e30f;
                    sc[jt][e] = lg; mx = fmaxf(mx, lg);
                }
            mx = fmaxf(mx, __shfl_xor(mx, 32));
#pragma unroll
            for (int jt = 0; jt < 5; ++jt)
#pragma unroll
                for (int e = 0; e < 16; ++e) { float pe = __expf(sc[jt][e] - mx); if (jt == 0 || jt == 4) pe = sc[jt][e] > -1.0e29f ? pe : 0.f; sc[jt][e] = pe; sum += pe; }
        } else {
#pragma unroll
            for (int jt = 0; jt < 5; ++jt)
#pragma unroll
                for (int e = 0; e < 16; ++e) {
                    const int m = (e & 3) + 8 * (e >> 2) + 4 * h2, rel = 32 * jt - 64 + m - n32, kp = qp + rel;
                    const bool ok = rel >= -64 && rel <= 64 && kp >= 0 && kp < Lq;
                    const float lg = ok ? sc[jt][e] * 0.125f + BT[ok ? rel + 64 : 64] : -1.0e30f;
                    sc[jt][e] = lg; mx = fmaxf(mx, lg);
                }
            mx = fmaxf(mx, __shfl_xor(mx, 32));
#pragma unroll
            for (int jt = 0; jt < 5; ++jt)
#pragma unroll
                for (int e = 0; e < 16; ++e) { const float pe = sc[jt][e] > -1.0e29f ? __expf(sc[jt][e] - mx) : 0.f; sc[jt][e] = pe; sum += pe; }
        }
        sum += __shfl_xor(sum, 32);
        f32x16 ot[2];
#pragma unroll
        for (int dt = 0; dt < 2; ++dt)
#pragma unroll
            for (int e = 0; e < 16; ++e) ot[dt][e] = 0.f;
#pragma unroll
        for (int jt = 0; jt < 5; ++jt)
#pragma unroll
            for (int s2 = 0; s2 < 2; ++s2) {
                u32x4 pb; pb.x = cvt_pk_bf16(sc[jt][8 * s2 + 0], sc[jt][8 * s2 + 1]); pb.y = cvt_pk_bf16(sc[jt][8 * s2 + 2], sc[jt][8 * s2 + 3]); pb.z = cvt_pk_bf16(sc[jt][8 * s2 + 4], sc[jt][8 * s2 + 5]); pb.w = cvt_pk_bf16(sc[jt][8 * s2 + 6], sc[jt][8 * s2 + 7]);
                const int kb = 32 * wid + 32 * jt + 16 * s2 + 4 * h2;
#pragma unroll
                for (int dt = 0; dt < 2; ++dt) {
                    ldsp vp = L + A_VT + ((32 * dt + n32) * A_VTP + kb) * 2;
                    const u32x2 lo = *(LAS const u32x2*)vp, hi = *(LAS const u32x2*)(vp + 16); u32x4 va; va.x = lo.x; va.y = lo.y; va.z = hi.x; va.w = hi.y;
                    ot[dt] = MFMA32(as_bf16x8(va), as_bf16x8(pb), ot[dt]);
                }
            }
        const float inv = 1.f / sum;
        bf16_t* orow = ao + qtok * 768 + head * 64;
#pragma unroll
        for (int dt = 0; dt < 2; ++dt)
#pragma unroll
            for (int g4 = 0; g4 < 4; ++g4) { u32x2 v; v.x = cvt_pk_bf16(ot[dt][4 * g4] * inv, ot[dt][4 * g4 + 1] * inv); v.y = cvt_pk_bf16(ot[dt][4 * g4 + 2] * inv, ot[dt][4 * g4 + 3] * inv);
                *(u32x2*)(orow + 32 * dt + 8 * g4 + 4 * h2) = v; }
        if (h2 == 0) lse[qtok * 12 + head] = mx + __logf(sum);
    }
}
__device__ __forceinline__ void attn_combine_phase(const int tid, const bf16_t* __restrict__ ao, const float* __restrict__ lse, bf16_t* __restrict__ dst) {
    constexpr int U = 4;
    const size_t S = (size_t)gridDim.x * NTHR, NE = (size_t)MTOK * 96;
    for (size_t e0 = (size_t)blockIdx.x * NTHR + tid; e0 < NE; e0 += S * U) {
        float l0[U], l1[U], l2[U], lh[U]; u32x4 a[U];
#pragma unroll
        for (int u = 0; u < U; ++u) { const size_t e = e0 + u * S < NE ? e0 + u * S : e0; const size_t t = e / 96; const int c8 = (int)(e % 96), head = c8 >> 3, i = head & 3;
            l0[u] = lse[t * 12 + i]; l1[u] = lse[t * 12 + 4 + i]; l2[u] = lse[t * 12 + 8 + i]; lh[u] = lse[t * 12 + head]; a[u] = *(const u32x4*)(ao + e * 8); }
#pragma unroll
        for (int u = 0; u < U; ++u) { const size_t e = e0 + u * S; if (e >= NE) break;
            const float m = fmaxf(l0[u], fmaxf(l1[u], l2[u])), al = __expf(lh[u] - m) / (__expf(l0[u] - m) + __expf(l1[u] - m) + __expf(l2[u] - m));
            u32x4 v; v.x = cvt_pk_bf16(bf_lo(a[u].x) * al, bf_hi(a[u].x) * al); v.y = cvt_pk_bf16(bf_lo(a[u].y) * al, bf_hi(a[u].y) * al); v.z = cvt_pk_bf16(bf_lo(a[u].z) * al, bf_hi(a[u].z) * al); v.w = cvt_pk_bf16(bf_lo(a[u].w) * al, bf_hi(a[u].w) * al);
            *(u32x4*)(dst + e * 8) = v; }
    }
}

#define XB_TMO      128
#define XB_XCNT(j)  (256  + 64 * (j))
#define XB_XSUB(j)  (1280 + 64 * (j))
#define XB_XGEN(j)  (2304 + 64 * (j))
#define XB_TOP      3328
#define XB_TOPGEN   3392
#define XCD_BAR_WORDS 3456
#define XB_SPIN_CAP (1u << 20)
__device__ __forceinline__ unsigned xb_ld(unsigned* p)              { return __hip_atomic_load(p, __ATOMIC_RELAXED, __HIP_MEMORY_SCOPE_AGENT); }
__device__ __forceinline__ unsigned xb_add(unsigned* p, unsigned v) { return __hip_atomic_fetch_add(p, v, __ATOMIC_RELAXED, __HIP_MEMORY_SCOPE_AGENT); }
__device__ __forceinline__ unsigned xb_xcc_id() { return (unsigned)__builtin_amdgcn_s_getreg((3 << 11) | 20) & 0xFu; }
#define XB_SPIN(cond, bar) do { unsigned _sp = 0; while (cond) { __builtin_amdgcn_s_sleep(1); \
    if ((++_sp & 255u) == 0u) { if (xb_ld(&(bar)[XB_TMO])) break; if (_sp > XB_SPIN_CAP) { atomicAdd(&(bar)[XB_TMO], 1u); break; } } } } while (0)
struct XcdBarrier { unsigned* bar; unsigned x; volatile LAS unsigned* st; };
__device__ __forceinline__ XcdBarrier xcd_barrier_post(unsigned* bar, volatile LAS unsigned* st) {
    XcdBarrier b; b.bar = bar; b.x = xb_xcc_id(); b.st = st;
    if (threadIdx.x == 0) (void)xb_add(&bar[XB_XCNT(b.x)], 1u);
    return b;
}
__device__ __forceinline__ void xcd_barrier_complete(unsigned* bar, unsigned x, unsigned& nloc, unsigned& nx) {
    const unsigned G = gridDim.x * gridDim.y * gridDim.z;
    unsigned sum, cnt, mine, sp = 0u;
    for (;;) {
        sum = 0u; cnt = 0u; mine = 0u;
#pragma unroll
        for (unsigned j = 0; j < 16; ++j) { const unsigned c = xb_ld(&bar[XB_XCNT(j)]); sum += c; cnt += (c > 0u) ? 1u : 0u; mine = (j == x) ? c : mine; }
        if (sum == G) break;
        __builtin_amdgcn_s_sleep(1);
        if ((++sp & 255u) == 0u) { if (xb_ld(&bar[XB_TMO])) break; if (sp > XB_SPIN_CAP) { atomicAdd(&bar[XB_TMO], 1u); break; } }
    }
    nloc = mine > 0u ? mine : 1u; nx = cnt > 0u ? cnt : 1u;
}
__device__ __forceinline__ void xcd_barrier(const XcdBarrier& b) {
    asm volatile("s_waitcnt vmcnt(0)" ::: "memory");
    __syncthreads();
    if (threadIdx.x == 0) {
        unsigned* bar = b.bar;
        __builtin_amdgcn_s_waitcnt(0);
        unsigned nloc = b.st[0], nx = b.st[1];
        if (nloc == 0u) { xcd_barrier_complete(bar, b.x, nloc, nx); b.st[0] = nloc; b.st[1] = nx; }
        const unsigned old = xb_add(&bar[XB_XSUB(b.x)], 1u);
        const unsigned gen = old / nloc;
        if (old + 1u == (gen + 1u) * nloc) {
            __builtin_amdgcn_fence(__ATOMIC_RELEASE, "agent");
            asm volatile("s_waitcnt vmcnt(0)" ::: "memory");
            const unsigned og = xb_add(&bar[XB_TOP], 1u);
            const unsigned tg = og / nx;
            if (og + 1u == (tg + 1u) * nx) xb_add(&bar[XB_TOPGEN], 1u);
            else XB_SPIN(xb_ld(&bar[XB_TOPGEN]) == tg, bar);
            __builtin_amdgcn_fence(__ATOMIC_ACQUIRE, "agent");
            xb_add(&bar[XB_XGEN(b.x)], 1u);
            asm volatile("s_waitcnt vmcnt(0)" ::: "memory");
        } else {
            XB_SPIN(xb_ld(&bar[XB_XGEN(b.x)]) == gen, bar);
            __builtin_amdgcn_fence(__ATOMIC_ACQUIRE, "agent");
            asm volatile("s_waitcnt vmcnt(0)" ::: "memory");
        }
    }
    __syncthreads();
}

struct EpiBf16Any {
    static constexpr bool PERM = true, AFTER_DRAIN = false;
    bf16_t* O; int ldc; int gdn; bf16_t* z; float* gates; bf16_t* halo;
    __device__ __forceinline__ void operator()(const f32x4 (&acc)[2][2][4][2], const Unit& u, int wr, int wc, int fr, int fq) const {
        const int row0 = u.pm * 256 + wr * 64 + fr;
        bf16_t* base = O; int ld = ldc, colt = u.pn * 256;
        if (gdn) {
            if (u.pn >= 16) {
                if (wc == 0) {
#pragma unroll
                    for (int ai = 0; ai < 2; ++ai)
#pragma unroll
                        for (int m = 0; m < 4; ++m) { float* g = gates + (size_t)(row0 + ai * 128 + m * 16) * 32 + 8 * fq; *(f32x4*)g = acc[ai][0][m][0]; *(f32x4*)(g + 4) = acc[ai][0][m][1]; }
                }
                return;
            }
            if (u.pn >= 12) { base = z; ld = 1024; colt = (u.pn - 12) * 256; }
        }
        const int col0 = colt + wc * 32 + 8 * fq;
#pragma unroll
        for (int ai = 0; ai < 2; ++ai)
#pragma unroll
            for (int m = 0; m < 4; ++m) { bf16_t* rowp = base + (size_t)(row0 + ai * 128 + m * 16) * ld + col0;
#pragma unroll
                for (int bj = 0; bj < 2; ++bj) { const f32x4 v0 = acc[ai][bj][m][0], v1 = acc[ai][bj][m][1]; u32x4 o; o.x = cvt_pk_bf16(v0[0], v0[1]); o.y = cvt_pk_bf16(v0[2], v0[3]); o.z = cvt_pk_bf16(v1[0], v1[1]); o.w = cvt_pk_bf16(v1[2], v1[3]);
                    *(u32x4*)(rowp + bj * 128) = o;
                    if (gdn && u.pn < 12 && ((m == 0 && fr < 2) || (m == 3 && fr >= 14))) {
                        const int r = row0 + ai * 128 + m * 16, rl = r & 63, hb = (r >> 6) + (rl >= 62 ? 1 : 0), hs = rl >= 62 ? rl - 62 : 2 + rl;
                        *(u32x4*)(halo + ((size_t)hb * 4 + hs) * 3072 + col0 + bj * 128) = o; } }
                asm volatile("" ::: "memory"); }
    }
};

__device__ __forceinline__ void prep_weights(const int tid, ldsp L, const Params& p, bf16_t* W, int wi_lo, int wi_hi, int tstart, int tstride) {
    for (int wi = wi_lo; wi < wi_hi; ++wi) {
        const float* src; bf16_t* dst; int K, N, Np;
        switch (wi) {
        case 0: src = p.in[5]; dst = W + W_GDN_IN; K = 1024; N = 4128; Np = 4352; break;
        case 1: src = p.in[10]; dst = W + W_GDN_OUT; K = 1024; N = 1024; Np = 1024; break;
        case 2: src = p.in[11]; dst = W + W_ATT_IN; K = 1024; N = 2304; Np = 2304; break;
        case 3: src = p.in[12]; dst = W + W_ATT_OUT; K = 768; N = 1024; Np = 1024; break;
        case 4: src = p.in[14]; dst = W + W_FFN_UP; K = 1024; N = 5632; Np = 5632; break;
        case 5: src = p.in[14] + (size_t)1024 * 5632; dst = W + W_FFN_UP + (size_t)5632 * 1024; K = 1024; N = 5632; Np = 5632; break;
        case 6: src = p.in[17]; dst = W + W_FFN_DOWN; K = 2816; N = 1024; Np = 1024; break;
        default: src = p.in[17] + (size_t)2816 * 1024; dst = W + W_FFN_DOWN + (size_t)1024 * 2816; K = 2816; N = 1024; Np = 1024; break;
        }
        wt_convert(tid, L, src, dst, K, N, Np, (wi == 4 || wi == 5) ? 1 : 0, tstart, tstride);
    }
}
enum { K_PREP = 0, K_RMS, K_GEMM_BF16, K_GEMM_RESID, K_GDNLOC, K_GDN, K_GDNCOMB, K_GEMM_UP, K_FIX, K_ATT, K_ATTCOMB, K_FINAL };
constexpr int NPHASE = 21;
__device__ __forceinline__ void decode_phase(int ph, int& kind, int& which, int& layer, bool& sync) {
    layer = 0; which = 0; sync = true;
    switch (ph) {
    case 0: kind = K_PREP; sync = false; break;
    case 1: kind = K_RMS; which = 0; break;
    case 2: kind = K_GEMM_BF16; which = 0; break;
    case 3: kind = K_GDNLOC; break;
    case 4: kind = K_GDN; break;
    case 5: kind = K_GDNCOMB; break;
    case 6: kind = K_GEMM_RESID; which = 0; break;
    case 7: kind = K_RMS; which = 1; break;
    case 8: kind = K_GEMM_UP; break;
    case 9: kind = K_FIX; break;
    case 10: kind = K_GEMM_RESID; which = 1; break;
    case 11: kind = K_RMS; which = 2; break;
    case 12: kind = K_GEMM_BF16; which = 2; break;
    case 13: kind = K_ATT; break;
    case 14: kind = K_ATTCOMB; break;
    case 15: kind = K_GEMM_RESID; which = 2; break;
    case 16: kind = K_RMS; which = 3; break;
    case 17: kind = K_GEMM_UP; layer = 1; break;
    case 18: kind = K_FIX; layer = 1; break;
    case 19: kind = K_GEMM_RESID; which = 1; layer = 1; break;
    default: kind = K_FINAL; sync = false; break;
    }
}

__global__ void __launch_bounds__(512, 2) mega_fwd(Params p) {
    extern __shared__ __attribute__((aligned(16))) unsigned char shm[];
    ldsp L = (ldsp)shm;
    cg::grid_group grid = cg::this_grid();
    __shared__ uint4 xb_words;
    if (threadIdx.x == 0) xb_words = make_uint4(0u, 0u, 0u, 0u);
    __syncthreads();
    const XcdBarrier xb = xcd_barrier_post((unsigned*)(p.ws + WS_BAR), (volatile LAS unsigned*)&xb_words);
#ifdef PROBE
    unsigned long long pr_acc[2] = {0ull, 0ull}; const unsigned long long pr_start = __builtin_amdgcn_s_memrealtime();
#endif
    for (int ph = 0; ph < NPHASE; ++ph) {
#ifdef PROBE
        const unsigned long long pr_t0 = __builtin_amdgcn_s_memrealtime();
#endif
        int tid; asm volatile("v_mov_b32 %0, %1" : "=v"(tid) : "v"((int)threadIdx.x));
        unsigned char* ws = p.ws;
        bf16_t* W = (bf16_t*)(ws + WS_W);
        bf16_t* R1 = (bf16_t*)(ws + WS_R1); bf16_t* R2 = (bf16_t*)(ws + WS_R2); bf16_t* R3 = (bf16_t*)(ws + WS_R3); float* R4 = (float*)(ws + WS_R4);
        bf16_t* hmid = R3; float* raw = (float*)(R3 + (size_t)MTOK * 2816);
        bf16_t* ao = R3 + (size_t)MTOK * 2304; bf16_t* XB = (bf16_t*)p.out + (size_t)MTOK * 1024;
        int kind, which, layer; bool sync;
        decode_phase(ph, kind, which, layer, sync);
        switch (kind) {
        case K_PREP:
            prep_weights(tid, L, p, W, 0, gridDim.x == 256 ? 2 : 8, (int)blockIdx.x, (int)gridDim.x); break;
        case K_RMS: {
            const float* w = which == 0 ? p.in[2] : (which == 1 ? p.in[3] : (which == 2 ? p.in[2] + 1024 : p.in[3] + 1024));
            if (which == 0) rmsnorm_f32in_phase(tid, p.in[0], p.in[1], TPROMPT, w, R1);
            else rmsnorm_bf16_phase(tid, which == 3 ? (const bf16_t*)R1 : (const bf16_t*)XB, w, which == 3 ? R2 : R1);
        } break;
        case K_GEMM_BF16: {
            EpiBf16Any E; E.gdn = 0; E.z = R2; E.gates = R4; E.halo = (bf16_t*)(ws + WS_HALO); const bf16_t* A; const bf16_t* Bt; int M, N;
            if (which == 0) { A = R1; Bt = W + W_GDN_IN; M = MTOK; N = 4352; E.O = R3; E.ldc = 3072; E.gdn = 1; }
            else { A = R1; Bt = W + W_ATT_IN; M = MTOK; N = 2304; E.O = R3; E.ldc = 2304; }
            run_gemm(tid, L, A, Bt, M, N, 1024, E);
        } break;
        case K_GEMM_RESID: {
            EpiResid E; E.outf = nullptr; E.ob = nullptr; E.r0 = p.in[0]; E.r1 = p.in[1]; E.split = TPROMPT; E.rb = nullptr; const bf16_t* A; const bf16_t* Bt; int M, K;
            if (which == 0) { A = R3; Bt = W + W_GDN_OUT; M = MTOK; K = 1024; E.ob = XB; }
            else if (which == 1) { A = hmid; Bt = W + W_FFN_DOWN + (size_t)layer * 1024 * 2816; M = MTOK; K = 2816;
                if (layer == 0) { E.rb = XB; E.ob = XB; }
                else { E.rb = R1; E.ob = R2; } }
            else { A = R2; Bt = W + W_ATT_OUT; M = MTOK; K = 768; E.rb = XB; E.ob = R1; }
            run_gemm(tid, L, A, Bt, M, 1024, K, E);
        } break;
        case K_GDNLOC: gdn_local_phase(tid, L, p, R3, (const bf16_t*)(ws + WS_HALO), R4, R1, (bf16_t*)p.out, (bf16_t*)p.out + (size_t)MTOK * 1024, (float*)(ws + WS_GSC)); break;
        case K_GDN: gdn_scan_phase(tid, L, R3, R1, (bf16_t*)p.out, (const bf16_t*)p.out + (size_t)MTOK * 1024, (const float*)(ws + WS_GSC), (bf16_t*)(ws + WS_OPF), (bf16_t*)(ws + WS_OPB));
            if (gridDim.x == 256 && blockIdx.x >= 128) { __syncthreads(); prep_weights(tid, L, p, W, 2, 8, (int)blockIdx.x - 128, 128); }
            break;
        case K_GDNCOMB: gdn_combine_phase(tid, L, p, R1, (const bf16_t*)p.out, R2, R3, (const bf16_t*)(ws + WS_OPF), (const bf16_t*)(ws + WS_OPB)); break;
        case K_GEMM_UP: {
            EpiFfnUp E; E.hmid = hmid; E.raw = raw; E.cw = p.in[15] + (size_t)layer * 3 * 5632; E.cb = p.in[16] + (size_t)layer * 5632; E.X = L + LDS_XCHG;
            run_gemm(tid, L, layer == 0 ? R1 : R2, W + W_FFN_UP + (size_t)layer * 5632 * 1024, MTOK, 5632, 1024, E);
        } break;
        case K_FIX: ffn_fix_phase(tid, raw, hmid, p.in[15] + (size_t)layer * 3 * 5632, p.in[16] + (size_t)layer * 5632); break;
#ifndef NO_ATT
        case K_ATT: attn_phase(tid, L, p, R3, ao, R4); break;
#endif
        case K_ATTCOMB: attn_combine_phase(tid, ao, R4, R2); break;
#ifdef PROBE
        default: rmsnorm_final_bf16_phase(tid, R2, p.in[4], p.out, *(volatile float*)(ws + WS_END)); break;
#else
        default: rmsnorm_final_bf16_phase(tid, R2, p.in[4], p.out, 0.f); break;
#endif
        }
#ifdef PROBE
        if (ph == NPHASE - 2 && blockIdx.x == 0 && threadIdx.x == 0) {
            const unsigned long long now = __builtin_amdgcn_s_memrealtime(); if (PROBE_A(kind)) pr_acc[0] += now - pr_t0; if (PROBE_B(kind)) pr_acc[1] += now - pr_t0;
            const float tot = (float)(now - pr_start); const float fa = fminf(rintf(100.f * (float)pr_acc[0] / tot), 99.f), fb = fminf(rintf(100.f * (float)pr_acc[1] / tot), 99.f);
            const float V = (fa + fb * 0.01f) * 0.01f; *(volatile float*)(ws + WS_END) = sqrtf(V * 1.0e-4f * 1.0004f);
            __threadfence();
        }
#endif
        if (sync) { if (ph == 1) grid.sync(); else xcd_barrier(xb); }
#ifdef PROBE
        if (ph < NPHASE - 2) { const unsigned long long now = __builtin_amdgcn_s_memrealtime(); if (PROBE_A(kind)) pr_acc[0] += now - pr_t0; if (PROBE_B(kind)) pr_acc[1] += now - pr_t0; }
#endif
    }
}

extern "C" void kernel_launch(void* const* d_in, const int* in_sizes, int n_in, void* d_out, int out_size, void* d_ws, size_t ws_size, hipStream_t stream) {
    static int grid_blocks = 0;
    if (grid_blocks == 0) {
        if (n_in != 18 || ws_size < WS_END) { fprintf(stderr, "kernel_launch: unexpected n_in %d / ws_size %zu\n", n_in, ws_size); grid_blocks = -1; return; }
        int dev = 0, cus = 0, per_cu = 0;
        hipGetDevice(&dev); hipDeviceGetAttribute(&cus, hipDeviceAttributeMultiprocessorCount, dev);
        if (hipFuncSetAttribute((const void*)mega_fwd, hipFuncAttributeMaxDynamicSharedMemorySize, LDS_BYTES) != hipSuccess) { fprintf(stderr, "kernel_launch: hipFuncSetAttribute failed\n"); grid_blocks = -1; return; }
        if (hipOccupancyMaxActiveBlocksPerMultiprocessor(&per_cu, (const void*)mega_fwd, NTHR, LDS_BYTES) != hipSuccess || per_cu < 1) { fprintf(stderr, "kernel_launch: occupancy query gave %d\n", per_cu); per_cu = 1; }
        (void)hipGetLastError();
        grid_blocks = cus;
    }
    if (grid_blocks < 0) return;
    Params p{};
    for (int i = 0; i < 18; ++i) p.in[i] = (const float*)d_in[i];
    p.out = (float*)d_out; p.ws = (unsigned char*)d_ws;
    if (hipMemsetAsync((unsigned char*)d_ws + WS_BAR, 0, 16384, stream) != hipSuccess) { fprintf(stderr, "kernel_launch: memset of the barrier words failed\n"); return; }
    void* args[] = {&p};
    hipError_t e = hipLaunchCooperativeKernel((const void*)mega_fwd, dim3(grid_blocks), dim3(NTHR), args, LDS_BYTES, stream);
    if (e != hipSuccess) fprintf(stderr, "cooperative launch failed: %s (grid %d)\n", hipGetErrorString(e), grid_blocks);
}
```

```cpp
#include <hip/hip_runtime.h>
#include <hip/hip_cooperative_groups.h>
#include <cstdio>
namespace cg = cooperative_groups;
namespace pg8 {
#define PG8_LAS __attribute__((address_space(3)))
typedef unsigned short bf16_t;
typedef short bf16x8 __attribute__((ext_vector_type(8)));
typedef float f32x4 __attribute__((ext_vector_type(4)));
typedef unsigned u32x4 __attribute__((ext_vector_type(4)));
constexpr int BM = 256, BK = 64, HALF = 128, HTB = HALF * BK * 2  , STAGE_BYTES = 8 * HTB, NXCD = 8, WGM = 4;

__host__ __device__ __forceinline__ int lds_byte(int r, int c) { const int st = (r >> 4) * 2 + (c >> 5), rr = r & 15, cc = c & 31, ob = rr * 64 + cc * 2; return st * 1024 + (ob ^ (((ob >> 9) & 1) << 5)); }
__host__ __device__ __forceinline__ void stage_rc(int b, int& R, int& C) { const int st = b / 1024, sb = b % 1024, swz = sb ^ (((sb >> 9) & 1) << 5); R = (st >> 1) * 16 + swz / 64; C = (st & 1) * 32 + (swz % 64) / 2; }
__host__ __device__ __forceinline__ int perm32(int rho) { const int n = rho >> 4, i = rho & 15; return 8 * (i >> 2) + 4 * n + (i & 3); }

struct Unit { int pm, pn; };
struct Gemm { const bf16_t* A; const bf16_t* Bt; int M, N, K; };
struct StaticOrder {
    int nM, nN, nwg, G, c;
    __host__ __device__ void init(int M, int N, int G_, int c_) { nM = M / BM; nN = N / BM; nwg = nM * nN; G = G_; c = c_; }
    __host__ __device__ bool next(int i, Unit& u) const {
        const long L = (long)i * G + c; if (L >= nwg) return false;
        int wgid = (int)L; { const int q = nwg / NXCD, r = nwg % NXCD, xcd = wgid % NXCD, off = wgid / NXCD; wgid = (xcd < r ? xcd * (q + 1) : r * (q + 1) + (xcd - r) * q) + off; }
        const int nig = WGM * nN, gid = wgid / nig, fm = gid * WGM, gsz = (nM - fm) < WGM ? (nM - fm) : WGM;
        u.pm = fm + ((wgid % nig) % gsz); u.pn = (wgid % nig) / gsz; return true;
    }
    __device__ __forceinline__ void a_ready(const Unit&) const {}
    __device__ __forceinline__ void done(const Unit&) const {}
};
__device__ __forceinline__ unsigned cvt_pk_bf16(float lo, float hi) { unsigned r; asm volatile("v_cvt_pk_bf16_f32 %0, %1, %2" : "=v"(r) : "v"(lo), "v"(hi)); return r; }
template <class Epi, class Sched>
__device__ __forceinline__ void gemm_phase(PG8_LAS unsigned char* lds, const Gemm g, const Sched& S, const Epi& E, const int tid_in) {
    const int tid = tid_in, wid = __builtin_amdgcn_readfirstlane(tid >> 6), lane = tid & 63, wr = wid >> 2, wc = wid & 3, fr = lane & 15, fq = lane >> 4;
    const int K = g.K, nt = K / BK;
    unsigned voffA[2], voffB[2];
#pragma unroll
    for (int i = 0; i < 2; ++i) { int R, C; stage_rc(tid * 16 + i * 8192, R, C); const int Rb = Epi::PERM ? ((R & ~31) + perm32(R & 31)) : R;
        voffA[i] = (unsigned)(R * K + C) * 2u; voffB[i] = (unsigned)(Rb * K + C) * 2u; }
    const size_t kstep = (size_t)(BK * 2);
    const size_t hstep = (size_t)HALF * K * 2;
    const size_t tstep = 2 * hstep;
    const unsigned ldsw = (unsigned)wid * 1024u;
    const int aoff = lds_byte(wr * 64 + fr, fq * 8), boff = lds_byte(wc * 32 + fr, fq * 8);
#define PG8_SA(b, h) (((b) * 2 + (h)) * HTB)
#define PG8_SB(b, h) ((4 + (b) * 2 + (h)) * HTB)
#define PG8_STAGE(bufoff, gbase, voff) do { _Pragma("unroll") for (int _i = 0; _i < 2; ++_i) \
        __builtin_amdgcn_global_load_lds((const unsigned*)((const char*)(gbase) + (voff)[_i]), (PG8_LAS unsigned*)(lds + (bufoff) + ldsw + _i * 8192), 16, 0, 0); } while (0)
#define PG8_LDA(dst, b, h) do { _Pragma("unroll") for (int m = 0; m < 4; ++m) _Pragma("unroll") for (int k = 0; k < 2; ++k) dst[m][k] = *(const PG8_LAS bf16x8*)(lds + PG8_SA(b, h) + aoff + m * 2048 + k * 1024); } while (0)
#define PG8_LDB(dst, b, h) do { _Pragma("unroll") for (int n = 0; n < 2; ++n) _Pragma("unroll") for (int k = 0; k < 2; ++k) dst[n][k] = *(const PG8_LAS bf16x8*)(lds + PG8_SB(b, h) + boff + n * 2048 + k * 1024); } while (0)
#define PG8_MMA(ai, bj, At, Bt) do { __builtin_amdgcn_s_setprio(1); _Pragma("unroll") for (int m = 0; m < 4; ++m) _Pragma("unroll") for (int n = 0; n < 2; ++n) _Pragma("unroll") for (int k = 0; k < 2; ++k) \
        acc[ai][bj][m][n] = __builtin_amdgcn_mfma_f32_16x16x32_bf16(Bt[n][k], At[m][k], acc[ai][bj][m][n], 0, 0, 0); __builtin_amdgcn_s_setprio(0); } while (0)
#define PG8_WAIT_V(n) asm volatile("s_waitcnt vmcnt(" #n ")" ::: "memory")
#define PG8_WAIT_L(n) asm volatile("s_waitcnt lgkmcnt(" #n ")" ::: "memory")
#define PG8_BAR __builtin_amdgcn_s_barrier()
#define PG8_SCHED __builtin_amdgcn_sched_barrier(0)
    Unit cur, nxt; int ui = 0;
    if (!S.next(0, cur)) return;
    f32x4 acc[2][2][4][2];
#pragma unroll
    for (int a = 0; a < 2; ++a)
#pragma unroll
        for (int b = 0; b < 2; ++b)
#pragma unroll
            for (int m = 0; m < 4; ++m)
#pragma unroll
                for (int n = 0; n < 2; ++n) acc[a][b][m][n] = (f32x4){0.f, 0.f, 0.f, 0.f};
    bf16x8 At[4][2], B0[2][2], B1[2][2];
    const char* cA = (const char*)g.A + (size_t)cur.pm * tstep; const char* cB = (const char*)g.Bt + (size_t)cur.pn * tstep;
    S.a_ready(cur);
    PG8_STAGE(PG8_SB(0, 0), cB, voffB); PG8_STAGE(PG8_SA(0, 0), cA, voffA); PG8_STAGE(PG8_SB(0, 1), cB + hstep, voffB); PG8_STAGE(PG8_SA(0, 1), cA + hstep, voffA);
    if (wr == 1) PG8_BAR;
    PG8_WAIT_V(4); PG8_BAR;
    PG8_STAGE(PG8_SB(1, 0), cB + kstep, voffB); PG8_STAGE(PG8_SA(1, 0), cA + kstep, voffA); PG8_STAGE(PG8_SB(1, 1), cB + hstep + kstep, voffB);
    PG8_WAIT_V(6); PG8_BAR;
    for (;;) {
        const bool has_next = S.next(ui + 1, nxt);
        const char* nA = has_next ? (const char*)g.A + (size_t)nxt.pm * tstep : cA; const char* nB = has_next ? (const char*)g.Bt + (size_t)nxt.pn * tstep : cB;
        for (int t = 0; t < nt; t += 2) {
            const bool last = (t == nt - 2);
            const char* a1 = cA + (size_t)(t + 1) * kstep;
            const char* a2 = last ? nA : cA + (size_t)(t + 2) * kstep; const char* b2 = last ? nB : cB + (size_t)(t + 2) * kstep;
            const char* a3 = a2 + kstep; const char* b3 = b2 + kstep;
            if (last && has_next) S.a_ready(nxt);
            PG8_LDB(B0, 0, 0); PG8_SCHED; PG8_LDA(At, 0, 0); PG8_STAGE(PG8_SA(1, 1), a1 + hstep, voffA);
            PG8_WAIT_L(8); PG8_BAR; PG8_WAIT_L(0); PG8_MMA(0, 0, At, B0); PG8_BAR; PG8_SCHED;
            PG8_LDB(B1, 0, 1); PG8_STAGE(PG8_SB(0, 0), b2, voffB);
            PG8_BAR; PG8_WAIT_L(0); PG8_MMA(0, 1, At, B1); PG8_BAR;
            PG8_LDA(At, 0, 1); PG8_STAGE(PG8_SA(0, 0), a2, voffA);
            PG8_BAR; PG8_WAIT_L(0); PG8_MMA(1, 0, At, B0); PG8_BAR; PG8_SCHED;
            PG8_STAGE(PG8_SB(0, 1), b2 + hstep, voffB);
            PG8_WAIT_V(6); PG8_BAR; PG8_MMA(1, 1, At, B1); PG8_BAR;
            PG8_LDB(B0, 1, 0); PG8_SCHED; PG8_LDA(At, 1, 0); PG8_STAGE(PG8_SA(0, 1), a2 + hstep, voffA);
            PG8_WAIT_L(8); PG8_BAR; PG8_WAIT_L(0); PG8_MMA(0, 0, At, B0); PG8_BAR; PG8_SCHED;
            PG8_LDB(B1, 1, 1); PG8_STAGE(PG8_SB(1, 0), b3, voffB);
            PG8_BAR; PG8_WAIT_L(0); PG8_MMA(0, 1, At, B1); PG8_BAR;
            PG8_LDA(At, 1, 1); PG8_STAGE(PG8_SA(1, 0), a3, voffA);
            PG8_BAR; PG8_WAIT_L(0); PG8_MMA(1, 0, At, B0); PG8_BAR; PG8_SCHED;
            PG8_STAGE(PG8_SB(1, 1), b3 + hstep, voffB);
            PG8_WAIT_V(6); PG8_BAR; PG8_MMA(1, 1, At, B1); PG8_BAR;
        }
        if constexpr (!Epi::AFTER_DRAIN) { E(acc, cur, wr, wc, fr, fq); S.done(cur); }
        if (!has_next) break;
#pragma unroll
        for (int a = 0; a < 2; ++a)
#pragma unroll
            for (int b = 0; b < 2; ++b)
#pragma unroll
                for (int m = 0; m < 4; ++m)
#pragma unroll
                    for (int n = 0; n < 2; ++n) acc[a][b][m][n] = (f32x4){0.f, 0.f, 0.f, 0.f};
        cur = nxt; cA = nA; cB = nB; ++ui;
    }
    PG8_WAIT_V(0);
    if (wr == 0) PG8_BAR;
    PG8_BAR;
    if constexpr (Epi::AFTER_DRAIN) { E.fused(acc, cur, wr, wc, fr, fq, lds, wid, lane); S.done(cur); }
#undef PG8_SA
#undef PG8_SB
#undef PG8_STAGE
#undef PG8_LDA
#undef PG8_LDB
#undef PG8_MMA
#undef PG8_WAIT_V
#undef PG8_WAIT_L
#undef PG8_BAR
#undef PG8_SCHED
}
}

using pg8::bf16_t; using pg8::bf16x8; using pg8::f32x4; using pg8::u32x4; using pg8::Unit; using pg8::cvt_pk_bf16;
typedef unsigned u32x2 __attribute__((ext_vector_type(2)));
typedef float f32x16 __attribute__((ext_vector_type(16)));
#define LAS __attribute__((address_space(3)))
typedef LAS unsigned char* ldsp;

constexpr int MTOK = 81920, TPROMPT = 16384, TSAMP = 4096, DMODEL = 1024;
constexpr int LDS_BYTES = 131072 + 8192;
constexpr int LDS_XCHG = 131072;
constexpr int NTHR = 512;

constexpr size_t WS_W  = 0;
constexpr size_t WS_R1 = 67108864;
constexpr size_t WS_R2 = WS_R1 + 167772160;
constexpr size_t WS_R3 = WS_R2 + 167772160;
constexpr size_t WS_R4 = WS_R3 + 503316480;
constexpr size_t WS_HALO = WS_R4 + 10485760;
constexpr size_t WS_GSC = WS_HALO + 31481856;
constexpr size_t WS_BAR = 62914560;
constexpr size_t WS_OPF = WS_GSC + (size_t)20480 * 144 * 4;
constexpr size_t WS_OPB = WS_OPF + 33554432;
constexpr size_t WS_END = WS_OPB + 33554432;
constexpr size_t W_GDN_IN = 0, W_GDN_OUT = W_GDN_IN + (size_t)4352 * 1024, W_ATT_IN = W_GDN_OUT + (size_t)1024 * 1024, W_ATT_OUT = W_ATT_IN + (size_t)2304 * 1024,
                 W_FFN_UP = W_ATT_OUT + (size_t)1024 * 768, W_FFN_DOWN = W_FFN_UP + (size_t)2 * 5632 * 1024, W_TOTAL = W_FFN_DOWN + (size_t)2 * 1024 * 2816;
static_assert(W_TOTAL * 2 <= 62914560, "weights overflow");

struct Params { const float* in[18]; float* out; unsigned char* ws; };

__device__ __forceinline__ unsigned short f2bf(float f) { unsigned u = __float_as_uint(f); u += 0x7FFFu + ((u >> 16) & 1u); return (unsigned short)(u >> 16); }
__device__ __forceinline__ float bf_lo(unsigned u) { return __uint_as_float(u << 16); }
__device__ __forceinline__ float bf_hi(unsigned u) { return __uint_as_float(u & 0xffff0000u); }
__device__ __forceinline__ float bf2f(unsigned short b) { return __uint_as_float(((unsigned)b) << 16); }
__device__ __forceinline__ float silu_f(float v) { return v * __builtin_amdgcn_rcpf(1.f + __expf(-v)); }
__device__ __forceinline__ bf16x8 as_bf16x8(u32x4 v) { union { u32x4 u; bf16x8 b; } c; c.u = v; return c.b; }
__device__ __forceinline__ bf16x8 pack8(f32x4 a, f32x4 b) { u32x4 v; v.x = cvt_pk_bf16(a[0], a[1]); v.y = cvt_pk_bf16(a[2], a[3]); v.z = cvt_pk_bf16(b[0], b[1]); v.w = cvt_pk_bf16(b[2], b[3]); return as_bf16x8(v); }
__device__ __forceinline__ bf16x8 lds_read2(ldsp p) { const u32x2 lo = *(LAS const u32x2*)p, hi = *(LAS const u32x2*)(p + 32); u32x4 v; v.x = lo.x; v.y = lo.y; v.z = hi.x; v.w = hi.y; return as_bf16x8(v); }
__device__ __forceinline__ void seq_bounds(int t, int& s0, int& s1) { if (t < TPROMPT) { s0 = 0; s1 = TPROMPT; } else { s0 = t & ~(TSAMP - 1); s1 = s0 + TSAMP; } }
#define FENCE() do { asm volatile("" ::: "memory"); __builtin_amdgcn_sched_barrier(0); } while (0)
__device__ __forceinline__ float dpp_prev16(float x) { return __int_as_float(__builtin_amdgcn_update_dpp(0, __float_as_int(x), 0x121, 0xF, 0xF, true)); }
__device__ __forceinline__ float dpp_next16(float x) { return __int_as_float(__builtin_amdgcn_update_dpp(0, __float_as_int(x), 0x12F, 0xF, 0xF, true)); }
#define MFMA16(a, b, c) __builtin_amdgcn_mfma_f32_16x16x32_bf16((a), (b), (c), 0, 0, 0)
#define MFMA32(a, b, c) __builtin_amdgcn_mfma_f32_32x32x16_bf16((a), (b), (c), 0, 0, 0)

__device__ __forceinline__ void wt_convert(const int tid, ldsp L, const float* __restrict__ w, bf16_t* __restrict__ bt, int K, int N, int Npad, int pairperm, int tstart, int tstride) {
    LAS float* tile = (LAS float*)L;
    const int nkt = K / 64, nnt = Npad / 64, ntile = nkt * nnt;
    for (int t = tstart; t < ntile; t += tstride) {
        const int kt = t % nkt, nt_ = t / nkt, k0 = kt * 64, n0 = nt_ * 64, s0n = pairperm ? (((n0 >> 7) & 1) * 2816 + (n0 >> 8) * 128 + (n0 & 127)) : n0;
#pragma unroll
        for (int i = 0; i < 8; ++i) { const int idx = tid + NTHR * i, kk = idx >> 6, nn = idx & 63; tile[kk * 65 + nn] = (s0n + nn < N) ? w[(size_t)(k0 + kk) * N + s0n + nn] : 0.f; }
        __syncthreads();
#pragma unroll
        for (int i = 0; i < 8; ++i) { const int idx = tid + NTHR * i, nn = idx >> 6, kk = idx & 63; bt[(size_t)(n0 + nn) * K + k0 + kk] = f2bf(tile[kk * 65 + nn]); }
        __syncthreads();
    }
}

template <bool FINAL>
__device__ __forceinline__ void rmsnorm_phase(const int tid, const float* x0, const float* x1, int split, const float* __restrict__ w, bf16_t* dst, float* fdst, const float pe = 0.f, const bf16_t* xb = nullptr) {
    const int lane = tid & 63, wid = tid >> 6;
    f32x4 wv[4];
#pragma unroll
    for (int j = 0; j < 4; ++j) wv[j] = *(const f32x4*)(w + lane * 4 + 256 * j);
    for (int row = blockIdx.x * 8 + wid; row < MTOK; row += gridDim.x * 8) {
        const float* xr = row < split ? x0 + (size_t)row * DMODEL : x1 + (size_t)(row - split) * DMODEL;
        f32x4 v[4]; float ss = 0.f;
#pragma unroll
        for (int j = 0; j < 4; ++j) { if (xb) { const u32x2 t = *(const u32x2*)(xb + (size_t)row * DMODEL + lane * 4 + 256 * j); v[j] = (f32x4){bf_lo(t.x), bf_hi(t.x), bf_lo(t.y), bf_hi(t.y)}; } else v[j] = *(const f32x4*)(xr + lane * 4 + 256 * j); ss += v[j][0] * v[j][0] + v[j][1] * v[j][1] + v[j][2] * v[j][2] + v[j][3] * v[j][3]; }
#pragma unroll
        for (int o = 32; o >= 1; o >>= 1) ss += __shfl_xor(ss, o);
        const float r = rsqrtf(ss * (1.f / 1024.f) + 1e-6f);
#pragma unroll
        for (int j = 0; j < 4; ++j) {
            const f32x4 y = v[j] * r * wv[j];
            if (FINAL) { f32x4 yy = y; yy[0] -= pe; yy[1] += pe; yy[2] -= pe; yy[3] += pe; *(f32x4*)(fdst + (size_t)row * DMODEL + lane * 4 + 256 * j) = yy; }
            else { u32x2 o2; o2.x = cvt_pk_bf16(y[0], y[1]); o2.y = cvt_pk_bf16(y[2], y[3]); *(u32x2*)(dst + (size_t)row * DMODEL + lane * 4 + 256 * j) = o2; }
        }
    }
}

__device__ __forceinline__ void rmsnorm_final_bf16_phase(const int tid, const bf16_t* __restrict__ xb, const float* __restrict__ w, float* __restrict__ out, const float pe) {
    const int lane = tid & 63, wid = tid >> 6, G8 = gridDim.x * 8;
    f32x4 wv[4];
#pragma unroll
    for (int j = 0; j < 2; ++j) { wv[2 * j] = *(const f32x4*)(w + 512 * j + lane * 8); wv[2 * j + 1] = *(const f32x4*)(w + 512 * j + lane * 8 + 4); }
    for (int rowb = blockIdx.x * 8 + wid; rowb < MTOK; rowb += 4 * G8) {
        u32x4 t[4][2];
#pragma unroll
        for (int u = 0; u < 4; ++u) { const int row = rowb + u * G8 < MTOK ? rowb + u * G8 : rowb;
#pragma unroll
            for (int j = 0; j < 2; ++j) t[u][j] = *(const u32x4*)(xb + (size_t)row * DMODEL + 512 * j + lane * 8); }
#pragma unroll
        for (int u = 0; u < 4; ++u) { const int row = rowb + u * G8;
            f32x4 v[4]; float ss = 0.f;
#pragma unroll
            for (int j = 0; j < 2; ++j) { v[2 * j] = (f32x4){bf_lo(t[u][j].x), bf_hi(t[u][j].x), bf_lo(t[u][j].y), bf_hi(t[u][j].y)}; v[2 * j + 1] = (f32x4){bf_lo(t[u][j].z), bf_hi(t[u][j].z), bf_lo(t[u][j].w), bf_hi(t[u][j].w)}; }
#pragma unroll
            for (int j = 0; j < 4; ++j) ss += v[j][0] * v[j][0] + v[j][1] * v[j][1] + v[j][2] * v[j][2] + v[j][3] * v[j][3];
#pragma unroll
            for (int o = 32; o >= 1; o >>= 1) ss += __shfl_xor(ss, o);
            const float r = rsqrtf(ss * (1.f / 1024.f) + 1e-6f);
            if (row < MTOK) {
#pragma unroll
                for (int j = 0; j < 4; ++j) { f32x4 y = v[j] * r * wv[j]; y[0] -= pe; y[1] += pe; y[2] -= pe; y[3] += pe; *(f32x4*)(out + (size_t)row * DMODEL + 512 * (j >> 1) + lane * 8 + 4 * (j & 1)) = y; }
            } }
    }
}

__device__ __forceinline__ void rmsnorm_f32in_phase(const int tid, const float* __restrict__ x0, const float* __restrict__ x1, int split, const float* __restrict__ w, bf16_t* __restrict__ dst) {
    const int lane = tid & 63, wid = tid >> 6, G8 = gridDim.x * 8;
    f32x4 wv[4];
#pragma unroll
    for (int j = 0; j < 2; ++j) { wv[2 * j] = *(const f32x4*)(w + 512 * j + lane * 8); wv[2 * j + 1] = *(const f32x4*)(w + 512 * j + lane * 8 + 4); }
    for (int rowb = blockIdx.x * 8 + wid; rowb < MTOK; rowb += 2 * G8) {
        f32x4 v[2][4];
#pragma unroll
        for (int u = 0; u < 2; ++u) { const int row = rowb + u * G8 < MTOK ? rowb + u * G8 : rowb; const float* xr = row < split ? x0 + (size_t)row * DMODEL : x1 + (size_t)(row - split) * DMODEL;
#pragma unroll
            for (int j = 0; j < 2; ++j) { v[u][2 * j] = *(const f32x4*)(xr + 512 * j + lane * 8); v[u][2 * j + 1] = *(const f32x4*)(xr + 512 * j + lane * 8 + 4); } }
#pragma unroll
        for (int u = 0; u < 2; ++u) { const int row = rowb + u * G8;
            float ss = 0.f;
#pragma unroll
            for (int j = 0; j < 4; ++j) ss += v[u][j][0] * v[u][j][0] + v[u][j][1] * v[u][j][1] + v[u][j][2] * v[u][j][2] + v[u][j][3] * v[u][j][3];
#pragma unroll
            for (int o = 32; o >= 1; o >>= 1) ss += __shfl_xor(ss, o);
            const float r = rsqrtf(ss * (1.f / 1024.f) + 1e-6f);
            if (row < MTOK) {
#pragma unroll
                for (int j = 0; j < 2; ++j) { const f32x4 y0 = v[u][2 * j] * r * wv[2 * j], y1 = v[u][2 * j + 1] * r * wv[2 * j + 1]; u32x4 o; o.x = cvt_pk_bf16(y0[0], y0[1]); o.y = cvt_pk_bf16(y0[2], y0[3]); o.z = cvt_pk_bf16(y1[0], y1[1]); o.w = cvt_pk_bf16(y1[2], y1[3]);
                    *(u32x4*)(dst + (size_t)row * DMODEL + 512 * j + lane * 8) = o; }
            } }
    }
}

__device__ __forceinline__ void rmsnorm_bf16_phase(const int tid, const bf16_t* __restrict__ xb, const float* __restrict__ w, bf16_t* __restrict__ dst) {
    const int lane = tid & 63, wid = tid >> 6, G8 = gridDim.x * 8;
    f32x4 wv[4];
#pragma unroll
    for (int j = 0; j < 2; ++j) { wv[2 * j] = *(const f32x4*)(w + 512 * j + lane * 8); wv[2 * j + 1] = *(const f32x4*)(w + 512 * j + lane * 8 + 4); }
    for (int rowb = blockIdx.x * 8 + wid; rowb < MTOK; rowb += 4 * G8) {
        u32x4 t[4][2];
#pragma unroll
        for (int u = 0; u < 4; ++u) { const int row = rowb + u * G8 < MTOK ? rowb + u * G8 : rowb;
#pragma unroll
            for (int j = 0; j < 2; ++j) t[u][j] = *(const u32x4*)(xb + (size_t)row * DMODEL + 512 * j + lane * 8); }
#pragma unroll
        for (int u = 0; u < 4; ++u) { const int row = rowb + u * G8;
            f32x4 v[4]; float ss = 0.f;
#pragma unroll
            for (int j = 0; j < 2; ++j) { v[2 * j] = (f32x4){bf_lo(t[u][j].x), bf_hi(t[u][j].x), bf_lo(t[u][j].y), bf_hi(t[u][j].y)}; v[2 * j + 1] = (f32x4){bf_lo(t[u][j].z), bf_hi(t[u][j].z), bf_lo(t[u][j].w), bf_hi(t[u][j].w)}; }
#pragma unroll
            for (int j = 0; j < 4; ++j) ss += v[j][0] * v[j][0] + v[j][1] * v[j][1] + v[j][2] * v[j][2] + v[j][3] * v[j][3];
#pragma unroll
            for (int o = 32; o >= 1; o >>= 1) ss += __shfl_xor(ss, o);
            const float r = rsqrtf(ss * (1.f / 1024.f) + 1e-6f);
            if (row < MTOK) {
#pragma unroll
                for (int j = 0; j < 2; ++j) { const f32x4 y0 = v[2 * j] * r * wv[2 * j], y1 = v[2 * j + 1] * r * wv[2 * j + 1]; u32x4 o; o.x = cvt_pk_bf16(y0[0], y0[1]); o.y = cvt_pk_bf16(y0[2], y0[3]); o.z = cvt_pk_bf16(y1[0], y1[1]); o.w = cvt_pk_bf16(y1[2], y1[3]);
                    *(u32x4*)(dst + (size_t)row * DMODEL + 512 * j + lane * 8) = o; }
            } }
    }
}

struct EpiResid {
    static constexpr bool PERM = true, AFTER_DRAIN = false;
    float* outf; bf16_t* ob; const float* r0; const float* r1; int split; const bf16_t* rb;
    __device__ __forceinline__ void load_resid(f32x4 (&rv)[2][2], int row, int col0) const {
        if (rb) { const bf16_t* rp = rb + (size_t)row * DMODEL + col0;
#pragma unroll
            for (int bj = 0; bj < 2; ++bj) { const u32x4 t = *(const u32x4*)(rp + bj * 128); rv[bj][0] = (f32x4){bf_lo(t.x), bf_hi(t.x), bf_lo(t.y), bf_hi(t.y)}; rv[bj][1] = (f32x4){bf_lo(t.z), bf_hi(t.z), bf_lo(t.w), bf_hi(t.w)}; } }
        else { const float* rp = (row < split ? r0 + (size_t)row * DMODEL : r1 + (size_t)(row - split) * DMODEL) + col0;
#pragma unroll
            for (int bj = 0; bj < 2; ++bj)
#pragma unroll
                for (int n = 0; n < 2; ++n) rv[bj][n] = *(const f32x4*)(rp + bj * 128 + n * 4); }
    }
    __device__ __forceinline__ void operator()(const f32x4 (&acc)[2][2][4][2], const Unit& u, int wr, int wc, int fr, int fq) const {
        const int row0 = u.pm * 256 + wr * 64 + fr, col0 = u.pn * 256 + wc * 32 + 8 * fq;
        f32x4 rv[2][2], rn[2][2];
        load_resid(rn, row0, col0);
#pragma unroll
        for (int g = 0; g < 8; ++g) { const int ai = g >> 2, m = g & 3, row = row0 + ai * 128 + m * 16;
#pragma unroll
            for (int bj = 0; bj < 2; ++bj)
#pragma unroll
                for (int n = 0; n < 2; ++n) rv[bj][n] = rn[bj][n];
            if (g < 7) load_resid(rn, row0 + ((g + 1) >> 2) * 128 + ((g + 1) & 3) * 16, col0);
            if (ob) { bf16_t* op = ob + (size_t)row * DMODEL + col0;
#pragma unroll
                for (int bj = 0; bj < 2; ++bj) { const f32x4 y0 = rv[bj][0] + acc[ai][bj][m][0], y1 = rv[bj][1] + acc[ai][bj][m][1]; u32x4 t; t.x = cvt_pk_bf16(y0[0], y0[1]); t.y = cvt_pk_bf16(y0[2], y0[3]); t.z = cvt_pk_bf16(y1[0], y1[1]); t.w = cvt_pk_bf16(y1[2], y1[3]);
                    *(u32x4*)(op + bj * 128) = t; } }
            else { float* op = outf + (size_t)row * DMODEL + col0;
#pragma unroll
                for (int bj = 0; bj < 2; ++bj)
#pragma unroll
                    for (int n = 0; n < 2; ++n) *(f32x4*)(op + bj * 128 + n * 4) = rv[bj][n] + acc[ai][bj][m][n]; }
            asm volatile("" ::: "memory"); }
    }
};

struct EpiFfnUp {
    static constexpr bool PERM = true, AFTER_DRAIN = false;
    bf16_t* hmid; float* raw; const float* cw; const float* cb; ldsp X;
    __device__ __forceinline__ void operator()(const f32x4 (&acc)[2][2][4][2], const Unit& u, int wr, int wc, int fr, int fq) const {
        LAS float* Xf = (LAS float*)X;
        const int cu0 = wc * 32 + 8 * fq;
#pragma unroll
        for (int ai = 0; ai < 2; ++ai) {
            if (fr == 0) {
#pragma unroll
                for (int bj = 0; bj < 2; ++bj)
#pragma unroll
                    for (int n = 0; n < 2; ++n) *(LAS f32x4*)(Xf + ((2 * ai + wr) * 2 + 0) * 256 + bj * 128 + cu0 + 4 * n) = acc[ai][bj][0][n];
            }
            if (fr == 15) {
#pragma unroll
                for (int bj = 0; bj < 2; ++bj)
#pragma unroll
                    for (int n = 0; n < 2; ++n) *(LAS f32x4*)(Xf + ((2 * ai + wr) * 2 + 1) * 256 + bj * 128 + cu0 + 4 * n) = acc[ai][bj][3][n];
            }
        }
        if (wr == 0 && fr < 2) {
#pragma unroll
            for (int bj = 0; bj < 2; ++bj)
#pragma unroll
                for (int n = 0; n < 2; ++n) *(f32x4*)(raw + ((size_t)u.pm * 4 + fr) * 5632 + bj * 2816 + u.pn * 128 + cu0 + 4 * n) = acc[0][bj][0][n];
        }
        if (wr == 1 && fr >= 14) {
#pragma unroll
            for (int bj = 0; bj < 2; ++bj)
#pragma unroll
                for (int n = 0; n < 2; ++n) *(f32x4*)(raw + ((size_t)u.pm * 4 + 2 + (fr - 14)) * 5632 + bj * 2816 + u.pn * 128 + cu0 + 4 * n) = acc[1][bj][3][n];
        }
        asm volatile("s_waitcnt lgkmcnt(0)" ::: "memory");
        __builtin_amdgcn_s_barrier();
        asm volatile("" ::: "memory");
        __builtin_amdgcn_s_barrier();
        asm volatile("" ::: "memory");
        u32x2 held[2][4];
#pragma unroll
        for (int n = 0; n < 2; ++n) {
            const int c = u.pn * 128 + cu0 + 4 * n;
            const f32x4 wv0 = *(const f32x4*)(cw + c), wv1 = *(const f32x4*)(cw + 5632 + c), wv2 = *(const f32x4*)(cw + 2 * 5632 + c), bv = *(const f32x4*)(cb + c);
            const f32x4 wg0 = *(const f32x4*)(cw + 2816 + c), wg1 = *(const f32x4*)(cw + 5632 + 2816 + c), wg2 = *(const f32x4*)(cw + 2 * 5632 + 2816 + c), bg = *(const f32x4*)(cb + 2816 + c);
#pragma unroll
            for (int ai = 0; ai < 2; ++ai) {
                const int blk = 2 * ai + wr;
                f32x4 xp[2], xn[2];
#pragma unroll
                for (int bj = 0; bj < 2; ++bj) {
                    xp[bj] = blk > 0 ? *(LAS const f32x4*)(Xf + ((blk - 1) * 2 + 1) * 256 + bj * 128 + cu0 + 4 * n) : (f32x4){0.f, 0.f, 0.f, 0.f};
                    xn[bj] = blk < 3 ? *(LAS const f32x4*)(Xf + ((blk + 1) * 2 + 0) * 256 + bj * 128 + cu0 + 4 * n) : (f32x4){0.f, 0.f, 0.f, 0.f};
                }
                f32x4 rpm1[2], rn0[2];
#pragma unroll
                for (int bj = 0; bj < 2; ++bj) {
#pragma unroll
                    for (int e = 0; e < 4; ++e) { rpm1[bj][e] = 0.f; rn0[bj][e] = dpp_next16(acc[ai][bj][0][n][e]); }
                }
#pragma unroll
                for (int m = 0; m < 4; ++m) {
                    f32x4 y[2];
#pragma unroll
                    for (int bj = 0; bj < 2; ++bj) {
                        const f32x4 cur = acc[ai][bj][m][n];
                        f32x4 rp, rn1;
#pragma unroll
                        for (int e = 0; e < 4; ++e) { rp[e] = dpp_prev16(cur[e]); rn1[e] = (m < 3) ? dpp_next16(acc[ai][bj][m < 3 ? m + 1 : 3][n][e]) : 0.f; }
                        const f32x4 pedge = (m > 0) ? rpm1[bj] : xp[bj], nedge = (m < 3) ? rn1 : xn[bj];
                        f32x4 prev, next;
#pragma unroll
                        for (int e = 0; e < 4; ++e) { prev[e] = (fr == 0) ? pedge[e] : rp[e]; next[e] = (fr == 15) ? nedge[e] : rn0[bj][e]; }
                        const f32x4 w0 = bj ? wg0 : wv0, w1 = bj ? wg1 : wv1, w2 = bj ? wg2 : wv2, b = bj ? bg : bv;
                        y[bj] = b + w0 * prev + w1 * cur + w2 * next;
                        rpm1[bj] = rp; rn0[bj] = rn1;
                    }
                    u32x2 o; o.x = cvt_pk_bf16(silu_f(y[1][0]) * y[0][0], silu_f(y[1][1]) * y[0][1]); o.y = cvt_pk_bf16(silu_f(y[1][2]) * y[0][2], silu_f(y[1][3]) * y[0][3]);
                    if (n == 0) held[ai][m] = o;
                    else { u32x4 o4; o4.x = held[ai][m].x; o4.y = held[ai][m].y; o4.z = o.x; o4.w = o.y; *(u32x4*)(hmid + (size_t)(u.pm * 256 + ai * 128 + wr * 64 + m * 16 + fr) * 2816 + c - 4) = o4; }
                }
            }
            asm volatile("" ::: "memory");
        }
    }
};
__device__ __forceinline__ void ffn_fix_phase(const int tid, const float* __restrict__ raw, bf16_t* __restrict__ hmid, const float* __restrict__ cw, const float* __restrict__ cb) {
    constexpr int NT = MTOK / 256, NITEM = NT * 2 * 352;
    for (int it = blockIdx.x * NTHR + tid; it < NITEM; it += gridDim.x * NTHR) {
        const int cgp = it % 352, te = it / 352, t = te >> 1, e = te & 1, c = cgp * 8, row = t * 256 + (e ? 255 : 0);
        int s0, s1; seq_bounds(row, s0, s1);
        const float* rc = raw + ((size_t)t * 4 + (e ? 3 : 0)) * 5632;
        const float* rpv = e ? raw + ((size_t)t * 4 + 2) * 5632 : (row > s0 ? raw + ((size_t)(t - 1) * 4 + 3) * 5632 : (const float*)nullptr);
        const float* rnx = e ? (row + 1 < s1 ? raw + ((size_t)(t + 1) * 4 + 0) * 5632 : (const float*)nullptr) : raw + ((size_t)t * 4 + 1) * 5632;
        float y[2][8];
#pragma unroll
        for (int g = 0; g < 2; ++g)
#pragma unroll
            for (int h = 0; h < 2; ++h) {
                const int cc = g * 2816 + c + 4 * h; const f32x4 zero = (f32x4){0.f, 0.f, 0.f, 0.f};
                const f32x4 xc = *(const f32x4*)(rc + cc), xp = rpv ? *(const f32x4*)(rpv + cc) : zero, xn = rnx ? *(const f32x4*)(rnx + cc) : zero;
                const f32x4 v = *(const f32x4*)(cb + cc) + *(const f32x4*)(cw + cc) * xp + *(const f32x4*)(cw + 5632 + cc) * xc + *(const f32x4*)(cw + 2 * 5632 + cc) * xn;
                y[g][4 * h] = v[0]; y[g][4 * h + 1] = v[1]; y[g][4 * h + 2] = v[2]; y[g][4 * h + 3] = v[3];
            }
        u32x4 o; o.x = cvt_pk_bf16(silu_f(y[1][0]) * y[0][0], silu_f(y[1][1]) * y[0][1]); o.y = cvt_pk_bf16(silu_f(y[1][2]) * y[0][2], silu_f(y[1][3]) * y[0][3]);
        o.z = cvt_pk_bf16(silu_f(y[1][4]) * y[0][4], silu_f(y[1][5]) * y[0][5]); o.w = cvt_pk_bf16(silu_f(y[1][6]) * y[0][6], silu_f(y[1][7]) * y[0][7]);
        *(u32x4*)(hmid + (size_t)row * 2816 + c) = o;
    }
}
template <class Epi>
__device__ __forceinline__ void run_gemm(const int tid, ldsp L, const bf16_t* A, const bf16_t* Bt, int M, int N, int K, const Epi& E) {
    pg8::Gemm g; g.A = A; g.Bt = Bt; g.M = M; g.N = N; g.K = K;
    pg8::StaticOrder S; S.init(M, N, (int)gridDim.x, (int)blockIdx.x);
#ifndef NO_GEMM
    pg8::gemm_phase<Epi, pg8::StaticOrder>(L, g, S, E, tid);
#endif
}

constexpr int P_QH = 0  , P_KH = 17408  , P_KT = 34816  , P_VT = 53248, P_LM0 = 71680  , P_LM1 = 89088, P_AT0 = 106496, P_AT1 = 115712, P_SC = 124928;
static_assert(P_SC + 2560 <= LDS_BYTES, "gdn local lds");
constexpr int S_QH = 0, S_KT = 17408, S_TW = 35840, S_AT = 45056, S_SC = 54272, S_BS = 55808  , S_WT = 2 * S_BS;
static_assert(S_WT + 17408 <= LDS_BYTES, "scan lds");
constexpr int GSC_STRIDE = 144;

__device__ __forceinline__ void gdn_local_phase(const int tid0, ldsp L, const Params& p, bf16_t* qkv, const bf16_t* __restrict__ halo, const float* __restrict__ gates,
                                                bf16_t* u_f, bf16_t* u_b, bf16_t* atb, float* gsc) {
    const float* convw = p.in[6];
    float pga = 0.f, pgb = 0.f;
    u32x4 xr[12];
#define P3_LOAD(itv) do { \
        int tidl; asm volatile("v_mov_b32 %0, %1" : "=v"(tidl) : "v"(tid0)); \
        if (tidl < 384) { \
            const int chunkl = (itv) >> 3, headl = (itv) & 7, t0l = chunkl * 64; int s0l, s1l; seq_bounds(t0l, s0l, s1l); \
            const int cgp = tidl % 48, rr = tidl / 48, tensor = cgp >> 4, c8 = (cgp & 15) * 8, col = tensor * 1024 + headl * 128 + c8; \
            _Pragma("unroll") for (int i = 0; i < 12; ++i) { const int lr = 8 * rr - 2 + i; const u32x4 zero = (u32x4){0u, 0u, 0u, 0u}; \
                if (lr < 0) xr[i] = (t0l > s0l) ? *(const u32x4*)(halo + ((size_t)chunkl * 4 + (lr + 2)) * 3072 + col) : zero; \
                else if (lr >= 64) xr[i] = (t0l + 64 < s1l) ? *(const u32x4*)(halo + ((size_t)(chunkl + 1) * 4 + (lr - 62)) * 3072 + col) : zero; \
                else xr[i] = *(const u32x4*)(qkv + (size_t)(t0l + lr) * 3072 + col); } } \
        else { const int dirl = (tidl >> 6) - 6, tl = ((itv) >> 3) * 64 + (tidl & 63), headl = (itv) & 7; \
            pga = gates[(size_t)tl * 32 + dirl * 8 + headl]; pgb = gates[(size_t)tl * 32 + (2 + dirl) * 8 + headl]; } } while (0)
    if ((int)blockIdx.x < (MTOK / 64) * 8) P3_LOAD((int)blockIdx.x);
    int cw_head = -1;
    for (int it = blockIdx.x; it < (MTOK / 64) * 8; it += gridDim.x) {
        int tid; asm volatile("v_mov_b32 %0, %1" : "=v"(tid) : "v"(tid0));
        const int wid = __builtin_amdgcn_readfirstlane(tid >> 6), lane = tid & 63, l15 = lane & 15, q4 = lane >> 4;
        const int chunk = it >> 3, head = it & 7, t0 = chunk * 64, slot = it;
        LAS float* CW = (LAS float*)(L + LDS_XCHG);
        if (head != cw_head) {
            for (int e = tid; e < 5 * 384; e += NTHR) { const int i = e / 384, cc = e % 384, tensor = cc >> 7, c = cc & 127; CW[e] = convw[i * 3072 + tensor * 1024 + head * 128 + c]; }
            cw_head = head;
            __syncthreads();
        }
        if (tid < 384) {
            const int cgp = tid % 48, rr = tid / 48, tensor = cgp >> 4, c8 = (cgp & 15) * 8;
#pragma unroll
            for (int hf = 0; hf < 2; ++hf) {
                float o[4][8];
#pragma unroll
                for (int r = 0; r < 4; ++r)
#pragma unroll
                    for (int c = 0; c < 8; ++c) o[r][c] = 0.f;
#pragma unroll
                for (int i = 0; i < 5; ++i) {
                    const f32x4 wa = *(LAS const f32x4*)(CW + i * 384 + tensor * 128 + c8), wb = *(LAS const f32x4*)(CW + i * 384 + tensor * 128 + c8 + 4);
#pragma unroll
                    for (int r = 0; r < 4; ++r) { const u32x4 x = xr[4 * hf + r + i];
                        o[r][0] += wa[0] * bf_lo(x.x); o[r][1] += wa[1] * bf_hi(x.x); o[r][2] += wa[2] * bf_lo(x.y); o[r][3] += wa[3] * bf_hi(x.y);
                        o[r][4] += wb[0] * bf_lo(x.z); o[r][5] += wb[1] * bf_hi(x.z); o[r][6] += wb[2] * bf_lo(x.w); o[r][7] += wb[3] * bf_hi(x.w); }
                }
#pragma unroll
                for (int r = 0; r < 4; ++r) {
                    float ss = 0.f;
#pragma unroll
                    for (int c = 0; c < 8; ++c) { o[r][c] = silu_f(o[r][c]); ss += o[r][c] * o[r][c]; }
                    ss += __shfl_xor(ss, 1); ss += __shfl_xor(ss, 2); ss += __shfl_xor(ss, 4); ss += __shfl_xor(ss, 8);
                    const float sc = tensor == 2 ? 1.f : rsqrtf(ss + 1e-6f) * (tensor == 0 ? 0.08838834764831845f : 1.f);
#pragma unroll
                    for (int c = 0; c < 8; ++c) o[r][c] *= sc;
                }
                if (tensor < 2) {
                    ldsp base = L + (tensor == 0 ? P_QH : P_KH) + (8 * rr + 4 * hf) * 272 + c8 * 2;
#pragma unroll
                    for (int r = 0; r < 4; ++r) { u32x4 v; v.x = cvt_pk_bf16(o[r][0], o[r][1]); v.y = cvt_pk_bf16(o[r][2], o[r][3]); v.z = cvt_pk_bf16(o[r][4], o[r][5]); v.w = cvt_pk_bf16(o[r][6], o[r][7]); *(LAS u32x4*)(base + r * 272) = v; }
                }
                if (tensor >= 1) {
                    ldsp base = L + (tensor == 1 ? P_KT : P_VT) + c8 * 144 + rr * 16 + hf * 8;
#pragma unroll
                    for (int c = 0; c < 8; ++c) { u32x2 v; v.x = cvt_pk_bf16(o[0][c], o[1][c]); v.y = cvt_pk_bf16(o[2][c], o[3][c]); *(LAS u32x2*)(base + c * 144) = v; }
                }
                FENCE();
            }
        } else {
            const int dir = wid - 6, t = t0 + lane;
            LAS float* SCgc = (LAS float*)(L + P_SC) + dir * 320;
            const float Aexp = expf(p.in[7][dir * 8 + head]), dtb = p.in[8][dir * 8 + head];
            const float a = pga, bb = pgb;
            const float x = a + dtb, sp = fmaxf(x, 0.f) + log1pf(expf(-fabsf(x))), g = -Aexp * sp, beta = 1.f / (1.f + expf(-bb));
            float pre = g;
#pragma unroll
            for (int o = 1; o < 64; o <<= 1) { const float y = __shfl_up(pre, o); if (lane >= o) pre += y; }
            const float tot = __shfl(pre, 63), gc = dir ? (tot - pre + g) : pre;
            const float egc = expf(gc), dec = expf(tot - gc), egl = expf(tot);
            SCgc[lane] = gc; SCgc[64 + lane] = beta; SCgc[128 + lane] = egc;
            float* gs = gsc + ((size_t)slot * 2 + dir) * GSC_STRIDE; gs[lane] = egc; gs[64 + lane] = dec; if (lane == 0) gs[128] = egl;
        }
        __syncthreads();
        if (it + (int)gridDim.x < (MTOK / 64) * 8) P3_LOAD(it + (int)gridDim.x);
#pragma unroll
        for (int j = 0; j < 2; ++j) { const int pi = tid + NTHR * j, row = pi >> 4, ch = pi & 15, dk = 2 * row + (ch >> 3);
            *(u32x4*)(qkv + (size_t)(t0 + row) * 3072 + head * 128 + ch * 8) = *(LAS const u32x4*)(L + P_QH + row * 272 + ch * 16);
            *(u32x4*)(qkv + (size_t)(t0 + row) * 3072 + 1024 + head * 128 + ch * 8) = *(LAS const u32x4*)(L + P_KT + dk * 144 + (ch & 7) * 16); }
        {
            const int mat = wid >> 2, rt = wid & 3;
            ldsp ab = L + (mat ? P_QH : P_KH) + (16 * rt + l15) * 272 + q4 * 16;
            bf16x8 af[4];
#pragma unroll
            for (int kk = 0; kk < 4; ++kk) af[kk] = *(LAS const bf16x8*)(ab + kk * 64);
            LAS const float* SC0 = (LAS const float*)(L + P_SC); LAS const float* SC1 = SC0 + 320;
#pragma unroll
            for (int ct = 0; ct < 4; ++ct) {
                ldsp bb = L + P_KH + (16 * ct + l15) * 272 + q4 * 16;
                f32x4 acc = (f32x4){0.f, 0.f, 0.f, 0.f};
#pragma unroll
                for (int kk = 0; kk < 4; ++kk) acc = MFMA16(af[kk], *(LAS const bf16x8*)(bb + kk * 64), acc);
                const int s = 16 * ct + l15; const float gs0 = SC0[s], gs1 = SC1[s];
#pragma unroll
                for (int j = 0; j < 4; ++j) {
                    const int c = 16 * rt + 4 * q4 + j; const float e0 = __expf(SC0[c] - gs0), e1 = __expf(SC1[c] - gs1);
                    if (mat == 0) {
                        ((LAS float*)(L + P_LM0))[c * 68 + s] = (s < c) ? acc[j] * SC0[64 + c] * e0 : 0.f;
                        ((LAS float*)(L + P_LM1))[(63 - c) * 68 + (63 - s)] = (s > c) ? acc[j] * SC1[64 + c] * e1 : 0.f;
                    } else {
                        *(LAS unsigned short*)(L + P_AT0 + c * 144 + s * 2) = f2bf((s <= c) ? acc[j] * e0 : 0.f);
                        *(LAS unsigned short*)(L + P_AT1 + c * 144 + s * 2) = f2bf((s >= c) ? acc[j] * e1 : 0.f);
                    }
                }
            }
        }
        __syncthreads();
        {
            if (tid < 128) {
                const int d = tid >> 6, t6 = tid & 63, b = t6 >> 4, j = t6 & 15;
                LAS const float* LM = (LAS const float*)(L + (d ? P_LM1 : P_LM0)); LAS float* TM = (LAS float*)(L + (d ? P_QH : P_KH)); float x[16];
#pragma unroll
                for (int i = 0; i < 16; ++i) { float a = (i == j) ? 1.f : 0.f;
#pragma unroll
                    for (int s = 0; s < i; ++s) a -= LM[(16 * b + i) * 68 + 16 * b + s] * x[s];
                    x[i] = a; TM[(16 * b + i) * 68 + 16 * b + j] = a; if ((i & 3) == 3) FENCE(); }
            } else {
                for (int e = tid - 128; e < 3072; e += NTHR - 128) { const int d = e >= 1536, e1 = d ? e - 1536 : e, blk = e1 >> 8, w = e1 & 255, i = w >> 4, j = w & 15;
                    const int bi = blk < 3 ? 0 : (blk < 5 ? 1 : 2), bj = blk < 3 ? blk + 1 : (blk < 5 ? blk - 1 : 3);
                    ((LAS float*)(L + (d ? P_QH : P_KH)))[(16 * bi + i) * 68 + 16 * bj + j] = 0.f; }
            }
            __syncthreads();
            if (tid < 256) {
                const int d = tid >> 7, t7 = tid & 127, hb = t7 >> 6, r0 = 32 * hb, i = (t7 & 63) >> 2, j4 = (t7 & 3) * 4; f32x4 y = (f32x4){0.f, 0.f, 0.f, 0.f};
                LAS const float* LM = (LAS const float*)(L + (d ? P_LM1 : P_LM0)); LAS const float* TM = (LAS const float*)(L + (d ? P_QH : P_KH)); LAS float* YS = (LAS float*)(L + P_KT + d * 4608);
#pragma unroll
                for (int k = 0; k < 16; k += 4) { const f32x4 a = *(LAS const f32x4*)(LM + (r0 + 16 + i) * 68 + r0 + k);
#pragma unroll
                    for (int kk = 0; kk < 4; ++kk) y += a[kk] * *(LAS const f32x4*)(TM + (r0 + k + kk) * 68 + r0 + j4); }
                *(LAS f32x4*)(YS + (hb * 16 + i) * 36 + j4) = y;
            }
            __syncthreads();
            if (tid < 256) {
                const int d = tid >> 7, t7 = tid & 127, hb = t7 >> 6, r0 = 32 * hb, i = (t7 & 63) >> 2, j4 = (t7 & 3) * 4; f32x4 y = (f32x4){0.f, 0.f, 0.f, 0.f};
                LAS float* TM = (LAS float*)(L + (d ? P_QH : P_KH)); LAS const float* YS = (LAS const float*)(L + P_KT + d * 4608);
#pragma unroll
                for (int k = 0; k < 16; k += 4) { const f32x4 a = *(LAS const f32x4*)(TM + (r0 + 16 + i) * 68 + r0 + 16 + k);
#pragma unroll
                    for (int kk = 0; kk < 4; ++kk) y -= a[kk] * *(LAS const f32x4*)(YS + (hb * 16 + k + kk) * 36 + j4); }
                *(LAS f32x4*)(TM + (r0 + 16 + i) * 68 + r0 + j4) = y;
            }
            __syncthreads();
            {
                const int d = tid >> 8, t8 = tid & 255, i = t8 >> 3, j4 = (t8 & 7) * 4; f32x4 y = (f32x4){0.f, 0.f, 0.f, 0.f};
                LAS const float* LM = (LAS const float*)(L + (d ? P_LM1 : P_LM0)); LAS const float* TM = (LAS const float*)(L + (d ? P_QH : P_KH)); LAS float* YS = (LAS float*)(L + P_KT + d * 4608);
#pragma unroll
                for (int k = 0; k < 32; k += 4) { const f32x4 a = *(LAS const f32x4*)(LM + (32 + i) * 68 + k);
#pragma unroll
                    for (int kk = 0; kk < 4; ++kk) y += a[kk] * *(LAS const f32x4*)(TM + (k + kk) * 68 + j4); }
                *(LAS f32x4*)(YS + i * 36 + j4) = y;
            }
            __syncthreads();
            {
                const int d = tid >> 8, t8 = tid & 255, i = t8 >> 3, j4 = (t8 & 7) * 4; f32x4 y = (f32x4){0.f, 0.f, 0.f, 0.f};
                LAS float* TM = (LAS float*)(L + (d ? P_QH : P_KH)); LAS const float* YS = (LAS const float*)(L + P_KT + d * 4608);
#pragma unroll
                for (int k = 0; k < 32; k += 4) { const f32x4 a = *(LAS const f32x4*)(TM + (32 + i) * 68 + 32 + k);
#pragma unroll
                    for (int kk = 0; kk < 4; ++kk) y -= a[kk] * *(LAS const f32x4*)(YS + (k + kk) * 36 + j4); }
                *(LAS f32x4*)(TM + (32 + i) * 68 + j4) = y;
            }
            __syncthreads();
#pragma unroll
            for (int dir = 0; dir < 2; ++dir) {
                LAS const float* TM = (LAS const float*)(L + (dir ? P_QH : P_KH)); LAS const float* SCd = (LAS const float*)(L + P_SC) + dir * 320;
                const int c = tid >> 3, s8 = (tid & 7) * 8, fc = dir ? 63 - c : c; float tb[8], tw[8];
#pragma unroll
                for (int e = 0; e < 8; ++e) { const int s = s8 + e, fs = dir ? 63 - s : s; const float tv = TM[fc * 68 + fs]; tb[e] = tv * SCd[64 + s]; tw[e] = tb[e] * SCd[128 + s]; }
                u32x4 v; v.x = cvt_pk_bf16(tb[0], tb[1]); v.y = cvt_pk_bf16(tb[2], tb[3]); v.z = cvt_pk_bf16(tb[4], tb[5]); v.w = cvt_pk_bf16(tb[6], tb[7]);
                u32x4 w2; w2.x = cvt_pk_bf16(tw[0], tw[1]); w2.y = cvt_pk_bf16(tw[2], tw[3]); w2.z = cvt_pk_bf16(tw[4], tw[5]); w2.w = cvt_pk_bf16(tw[6], tw[7]);
                *(u32x4*)(qkv + (size_t)(t0 + 32 * dir + (c >> 1)) * 3072 + 2048 + head * 128 + (c & 1) * 64 + s8) = w2;
                *(u32x4*)(atb + ((size_t)slot * 2 + dir) * 4096 + c * 64 + s8) = *(LAS const u32x4*)(L + (dir ? P_AT1 : P_AT0) + c * 144 + s8 * 2);
                *(LAS u32x4*)(L + P_LM0 + dir * 9216 + c * 144 + s8 * 2) = v;
            }
            __syncthreads();
#pragma unroll
            for (int dir = 0; dir < 2; ++dir) {
                const int dv0 = 16 * wid; f32x4 vn[4];
#pragma unroll
                for (int ct = 0; ct < 4; ++ct) vn[ct] = (f32x4){0.f, 0.f, 0.f, 0.f};
#pragma unroll
                for (int kk = 0; kk < 2; ++kk) { const bf16x8 bv = *(LAS const bf16x8*)(L + P_VT + (dv0 + l15) * 144 + kk * 64 + q4 * 16);
#pragma unroll
                    for (int ct = 0; ct < 4; ++ct) vn[ct] = MFMA16(*(LAS const bf16x8*)(L + P_LM0 + dir * 9216 + (16 * ct + l15) * 144 + kk * 64 + q4 * 16), bv, vn[ct]); }
                bf16_t* ub = (dir ? u_b : u_f) + ((size_t)slot * 128 + dv0 + l15) * 64 + 16 * q4;
#pragma unroll
                for (int h = 0; h < 2; ++h) { u32x4 v; v.x = cvt_pk_bf16(vn[2 * h][0], vn[2 * h][1]); v.y = cvt_pk_bf16(vn[2 * h][2], vn[2 * h][3]); v.z = cvt_pk_bf16(vn[2 * h + 1][0], vn[2 * h + 1][1]); v.w = cvt_pk_bf16(vn[2 * h + 1][2], vn[2 * h + 1][3]); *(u32x4*)(ub + 8 * h) = v; }
            }
            __syncthreads();
        }
    }
}

#undef P3_LOAD
__device__ __forceinline__ void gdn_scan_item(const int tid0, ldsp L, int gi, const int dvbase, const int nact, const bf16_t* __restrict__ qkv, bf16_t* u_f, bf16_t* u_b, const bf16_t* __restrict__ atb, const float* __restrict__ gsc, bf16_t* op_f, bf16_t* op_b) {
    int head, dir, tbase, nsteps;
    if (gi < 16) { head = gi & 7; dir = gi >> 3; tbase = 0; nsteps = TPROMPT / 64; }
    else { const int j = gi - 16; head = j & 7; dir = (j >> 3) & 1; tbase = TPROMPT + (j >> 4) * TSAMP; nsteps = TSAMP / 64; }
    bf16_t* ubuf = dir ? u_b : u_f; bf16_t* opbuf = dir ? op_b : op_f;
    f32x4 S[8];
#pragma unroll
    for (int i = 0; i < 8; ++i) S[i] = (f32x4){0.f, 0.f, 0.f, 0.f};
    u32x4 pq[2], pk[2], ptw, pat; u32x2 pu[4]; float psc = 0.f;
#pragma unroll
    for (int ct = 0; ct < 4; ++ct) pu[ct] = (u32x2){0u, 0u};
#define GDN_PREFETCH(stepv) do { \
        int tidp; asm volatile("v_mov_b32 %0, %1" : "=v"(tidp) : "v"(tid0)); \
        const int chunkp = dir ? nsteps - 1 - (stepv) : (stepv), t0p = tbase + 64 * chunkp, slotp = (t0p >> 6) * 8 + head, lanep = tidp & 63, widp = __builtin_amdgcn_readfirstlane(tidp >> 6); \
        const bf16_t* up = ubuf + ((size_t)slotp * 128 + dvbase + 16 * widp + (lanep & 15)) * 64 + 16 * (lanep >> 4); \
        if (widp < nact) { const u32x4 p01 = *(const u32x4*)up, p23 = *(const u32x4*)(up + 8); pu[0] = (u32x2){p01.x, p01.y}; pu[1] = (u32x2){p01.z, p01.w}; pu[2] = (u32x2){p23.x, p23.y}; pu[3] = (u32x2){p23.z, p23.w}; } \
        _Pragma("unroll") for (int j = 0; j < 2; ++j) { const int pi = tidp + NTHR * j, row = pi >> 4, ch = pi & 15; \
            pq[j] = *(const u32x4*)(qkv + (size_t)(t0p + row) * 3072 + head * 128 + ch * 8); pk[j] = *(const u32x4*)(qkv + (size_t)(t0p + row) * 3072 + 1024 + head * 128 + ch * 8); } \
        ptw = *(const u32x4*)(qkv + (size_t)(t0p + 32 * dir + (tidp >> 4)) * 3072 + 2048 + head * 128 + (tidp & 15) * 8); \
        pat = *(const u32x4*)(atb + ((size_t)slotp * 2 + dir) * 4096 + tidp * 8); \
        psc = (tidp < 129) ? gsc[((size_t)slotp * 2 + dir) * GSC_STRIDE + tidp] : 0.f; } while (0)
#define GDN_STAGE(bo) do { \
        int tids; asm volatile("v_mov_b32 %0, %1" : "=v"(tids) : "v"(tid0)); \
        _Pragma("unroll") for (int j = 0; j < 2; ++j) { const int pi = tids + NTHR * j, row = pi >> 4, ch = pi & 15, dk = 2 * row + (ch >> 3); \
            *(LAS u32x4*)(L + (bo) + S_QH + row * 272 + ch * 16) = pq[j]; *(LAS u32x4*)(L + (bo) + S_KT + dk * 144 + (ch & 7) * 16) = pk[j]; } \
        { const int c = 2 * (tids >> 4) + ((tids & 15) >> 3); *(LAS u32x4*)(L + (bo) + S_TW + c * 144 + (tids & 7) * 16) = ptw; } \
        *(LAS u32x4*)(L + (bo) + S_AT + (tids >> 3) * 144 + (tids & 7) * 16) = pat; \
        if (tids < 129) ((LAS float*)(L + (bo) + S_SC))[tids] = psc; } while (0)
    u32x2 uc[4], un[4];
    GDN_PREFETCH(0);
    GDN_STAGE(0);
#pragma unroll
    for (int ct = 0; ct < 4; ++ct) { uc[ct] = pu[ct]; un[ct] = pu[ct]; }
    if (nsteps > 1) GDN_PREFETCH(1);
    __syncthreads();
    for (int step = 0; step < nsteps; ++step) {
        int tid; asm volatile("v_mov_b32 %0, %1" : "=v"(tid) : "v"(tid0));
        const int wid = __builtin_amdgcn_readfirstlane(tid >> 6), lane = tid & 63, l15 = lane & 15, q4 = lane >> 4;
        const int chunk = dir ? nsteps - 1 - step : step, t0 = tbase + 64 * chunk, slot = (t0 >> 6) * 8 + head;
        const int bo = (step & 1) * S_BS, bn = S_BS - bo;
        {
            ldsp ab = L + bo + S_KT + (16 * wid + l15) * 144 + q4 * 16;
            const bf16x8 a0 = *(LAS const bf16x8*)ab, a1 = *(LAS const bf16x8*)(ab + 64);
#pragma unroll
            for (int ct = 0; ct < 4; ++ct) {
                ldsp bb = L + bo + S_TW + (16 * ct + l15) * 144 + q4 * 16;
                f32x4 acc = (f32x4){0.f, 0.f, 0.f, 0.f};
                acc = MFMA16(a0, *(LAS const bf16x8*)bb, acc); acc = MFMA16(a1, *(LAS const bf16x8*)(bb + 64), acc);
                u32x2 v; v.x = cvt_pk_bf16(-acc[0], -acc[1]); v.y = cvt_pk_bf16(-acc[2], -acc[3]);
                *(LAS u32x2*)(L + S_WT + (16 * ct + l15) * 272 + (16 * wid + 4 * q4) * 2) = v;
            }
        }
        __syncthreads();
        if (step + 1 < nsteps) {
            GDN_STAGE(bn);
#pragma unroll
            for (int ct = 0; ct < 4; ++ct) un[ct] = pu[ct];
            if (step + 2 < nsteps) GDN_PREFETCH(step + 2);
        }
        if (wid < nact) {
            const int dv0 = dvbase + 16 * wid;
            LAS const float* SCegc = (LAS const float*)(L + bo + S_SC); LAS const float* SCdec = SCegc + 64;
            f32x4 vn[4], R[4];
#pragma unroll
            for (int ct = 0; ct < 4; ++ct) { vn[ct][0] = bf_lo(uc[ct].x); vn[ct][1] = bf_hi(uc[ct].x); vn[ct][2] = bf_lo(uc[ct].y); vn[ct][3] = bf_hi(uc[ct].y); R[ct] = (f32x4){0.f, 0.f, 0.f, 0.f}; }
#pragma unroll
            for (int kk = 0; kk < 4; ++kk) {
                const bf16x8 sb = pack8(S[2 * kk], S[2 * kk + 1]);
#pragma unroll
                for (int ct = 0; ct < 4; ++ct) { const int off = (16 * ct + l15) * 272 + (32 * kk + 4 * q4) * 2;
                    vn[ct] = MFMA16(lds_read2(L + S_WT + off), sb, vn[ct]); R[ct] = MFMA16(lds_read2(L + bo + S_QH + off), sb, R[ct]); }
                FENCE();
            }
#pragma unroll
            for (int ct = 0; ct < 4; ++ct) R[ct] *= *(LAS const f32x4*)(SCegc + 16 * ct + 4 * q4);
            bf16x8 Vb[2], Vd[2];
#pragma unroll
            for (int kk = 0; kk < 2; ++kk) { Vb[kk] = pack8(vn[2 * kk], vn[2 * kk + 1]);
                Vd[kk] = pack8(vn[2 * kk] * *(LAS const f32x4*)(SCdec + 32 * kk + 4 * q4), vn[2 * kk + 1] * *(LAS const f32x4*)(SCdec + 32 * kk + 16 + 4 * q4)); }
            FENCE();
#pragma unroll
            for (int kk = 0; kk < 2; ++kk)
#pragma unroll
                for (int ct = 0; ct < 4; ++ct) R[ct] = MFMA16(lds_read2(L + bo + S_AT + (16 * ct + l15) * 144 + (32 * kk + 4 * q4) * 2), Vb[kk], R[ct]);
            if (opbuf) {
                bf16_t* ob = opbuf + ((size_t)slot * 128 + dv0 + l15) * 64 + 16 * q4;
#pragma unroll
                for (int h = 0; h < 2; ++h) { u32x4 v; v.x = cvt_pk_bf16(R[2 * h][0], R[2 * h][1]); v.y = cvt_pk_bf16(R[2 * h][2], R[2 * h][3]); v.z = cvt_pk_bf16(R[2 * h + 1][0], R[2 * h + 1][1]); v.w = cvt_pk_bf16(R[2 * h + 1][2], R[2 * h + 1][3]); *(u32x4*)(ob + 8 * h) = v; }
            } else {
                bf16_t* ob = ubuf + (size_t)slot * 8192 + dv0 + l15;
#pragma unroll
                for (int ct = 0; ct < 4; ++ct)
#pragma unroll
                    for (int j = 0; j < 4; ++j) ob[(16 * ct + 4 * q4 + j) * 128] = f2bf(R[ct][j]);
            }
            FENCE();
            const float egl = SCegc[128];
#pragma unroll
            for (int dkt = 0; dkt < 8; ++dkt) { S[dkt] *= egl;
#pragma unroll
                for (int kk = 0; kk < 2; ++kk) S[dkt] = MFMA16(lds_read2(L + bo + S_KT + (16 * dkt + l15) * 144 + (32 * kk + 4 * q4) * 2), Vd[kk], S[dkt]);
                if (dkt & 1) FENCE(); }
        }
#pragma unroll
        for (int ct = 0; ct < 4; ++ct) uc[ct] = un[ct];
        __syncthreads();
    }
#undef GDN_STAGE
#undef GDN_PREFETCH
}
constexpr int PSPLIT = 4;
__device__ __forceinline__ void gdn_scan_phase(const int tid, ldsp L, const bf16_t* qkv, bf16_t* u_f, bf16_t* u_b, const bf16_t* atb, const float* gsc, bf16_t* op_f, bf16_t* op_b) {
    const int b = blockIdx.x, G = gridDim.x;
    constexpr int NP = 16 * PSPLIT, NIT = NP + 256;
    for (int k = 0; k < 4; ++k) {
        int it;
        if (k == 0) it = b; else { if (b < NP || G <= NP) break; it = G + (k - 1) * (G - NP) + (b - NP); }
        if (it >= NIT) break;
        int gi, dvbase, nact; const bool prompt = it < NP;
        if (prompt) { gi = it / PSPLIT; dvbase = (it % PSPLIT) * (128 / PSPLIT); nact = 8 / PSPLIT; } else { gi = 16 + (it - NP); dvbase = 0; nact = 8; }
        __syncthreads();
        gdn_scan_item(tid, L, gi, dvbase, nact, qkv, u_f, u_b, atb, gsc, prompt ? op_f : (bf16_t*)nullptr, prompt ? op_b : (bf16_t*)nullptr);
    }
}

__device__ __forceinline__ void gdn_combine_phase(const int tid0, ldsp L, const Params& p, const bf16_t* o_f, const bf16_t* o_b, const bf16_t* z, bf16_t* dst, const bf16_t* __restrict__ op_f, const bf16_t* __restrict__ op_b) {
    const float* nw = p.in[9];
    LAS float* T = (LAS float*)L;
    for (int it = blockIdx.x; it < (TPROMPT / 64) * 8; it += gridDim.x) {
        int tid; asm volatile("v_mov_b32 %0, %1" : "=v"(tid) : "v"(tid0));
        const int chunk = it >> 3, head = it & 7, t0 = chunk * 64;
        __syncthreads();
#pragma unroll
        for (int j = 0; j < 2; ++j) { const int pi = tid + NTHR * j, dv = pi >> 3, c8 = (pi & 7) * 8; const size_t off = ((size_t)it * 128 + dv) * 64 + c8;
            const u32x4 a = *(const u32x4*)(op_f + off), b = *(const u32x4*)(op_b + off);
            const int cA = 16 * ((c8 >> 2) & 3) + 4 * (c8 >> 4), cB = cA + 16;
            T[(cA + 0) * 132 + dv] = bf_lo(a.x) + bf_lo(b.x); T[(cA + 1) * 132 + dv] = bf_hi(a.x) + bf_hi(b.x); T[(cA + 2) * 132 + dv] = bf_lo(a.y) + bf_lo(b.y); T[(cA + 3) * 132 + dv] = bf_hi(a.y) + bf_hi(b.y);
            T[(cB + 0) * 132 + dv] = bf_lo(a.z) + bf_lo(b.z); T[(cB + 1) * 132 + dv] = bf_hi(a.z) + bf_hi(b.z); T[(cB + 2) * 132 + dv] = bf_lo(a.w) + bf_lo(b.w); T[(cB + 3) * 132 + dv] = bf_hi(a.w) + bf_hi(b.w); }
        __syncthreads();
        const int c = tid >> 3, d16 = (tid & 7) * 16;
        float o[16]; float ss = 0.f;
#pragma unroll
        for (int e4 = 0; e4 < 4; ++e4) { const f32x4 v = *(LAS const f32x4*)(T + c * 132 + d16 + 4 * e4); o[4 * e4] = v[0]; o[4 * e4 + 1] = v[1]; o[4 * e4 + 2] = v[2]; o[4 * e4 + 3] = v[3]; ss += v[0] * v[0] + v[1] * v[1] + v[2] * v[2] + v[3] * v[3]; }
        ss += __shfl_xor(ss, 1); ss += __shfl_xor(ss, 2); ss += __shfl_xor(ss, 4);
        const float r = rsqrtf(ss * (1.f / 128.f) + 1e-6f);
        const size_t zoff = (size_t)(t0 + c) * 1024 + head * 128 + d16;
        const u32x4 z0 = *(const u32x4*)(z + zoff), z1 = *(const u32x4*)(z + zoff + 8);
        const unsigned zz[8] = {z0.x, z0.y, z0.z, z0.w, z1.x, z1.y, z1.z, z1.w};
        unsigned ov[8];
#pragma unroll
        for (int e2 = 0; e2 < 8; ++e2) { const float y0 = o[2 * e2] * r * nw[d16 + 2 * e2] * silu_f(bf_lo(zz[e2])), y1 = o[2 * e2 + 1] * r * nw[d16 + 2 * e2 + 1] * silu_f(bf_hi(zz[e2])); ov[e2] = cvt_pk_bf16(y0, y1); }
        u32x4 v0, v1; v0.x = ov[0]; v0.y = ov[1]; v0.z = ov[2]; v0.w = ov[3]; v1.x = ov[4]; v1.y = ov[5]; v1.z = ov[6]; v1.w = ov[7];
        *(u32x4*)(dst + zoff) = v0; *(u32x4*)(dst + zoff + 8) = v1;
    }
    int tid; asm volatile("v_mov_b32 %0, %1" : "=v"(tid) : "v"(tid0));
    const int lane = tid & 63, wid = tid >> 6, d8 = (lane & 15) * 8;
    const f32x4 w0 = *(const f32x4*)(nw + d8), w1 = *(const f32x4*)(nw + d8 + 4);
    const int SW = gridDim.x * 8;
    for (int it0 = TPROMPT * 2 + blockIdx.x * 8 + wid; it0 < MTOK * 2; it0 += 2 * SW) {
        u32x4 zz2[2], a2[2], b2[2];
#pragma unroll
        for (int u = 0; u < 2; ++u) { const int it = it0 + u * SW < MTOK * 2 ? it0 + u * SW : it0; const int tk = it >> 1, hd = (it & 1) * 4 + (lane >> 4);
            const size_t off = (size_t)tk * 1024 + (it & 1) * 512 + lane * 8, ooff = ((size_t)((tk >> 6) * 8 + hd) * 64 + (tk & 63)) * 128 + d8;
            zz2[u] = *(const u32x4*)(z + off); a2[u] = *(const u32x4*)(o_f + ooff); b2[u] = *(const u32x4*)(o_b + ooff); }
#pragma unroll
        for (int u = 0; u < 2; ++u) { const int it = it0 + u * SW; if (it >= MTOK * 2) break;
            const int tk = it >> 1; const size_t off = (size_t)tk * 1024 + (it & 1) * 512 + lane * 8;
            const u32x4 zz = zz2[u], a = a2[u], b = b2[u];
            float o[8];
            o[0] = bf_lo(a.x) + bf_lo(b.x); o[1] = bf_hi(a.x) + bf_hi(b.x); o[2] = bf_lo(a.y) + bf_lo(b.y); o[3] = bf_hi(a.y) + bf_hi(b.y); o[4] = bf_lo(a.z) + bf_lo(b.z); o[5] = bf_hi(a.z) + bf_hi(b.z); o[6] = bf_lo(a.w) + bf_lo(b.w); o[7] = bf_hi(a.w) + bf_hi(b.w);
            const float zf[8] = {bf_lo(zz.x), bf_hi(zz.x), bf_lo(zz.y), bf_hi(zz.y), bf_lo(zz.z), bf_hi(zz.z), bf_lo(zz.w), bf_hi(zz.w)};
            float ss = 0.f;
#pragma unroll
            for (int e = 0; e < 8; ++e) ss += o[e] * o[e];
            ss += __shfl_xor(ss, 1); ss += __shfl_xor(ss, 2); ss += __shfl_xor(ss, 4); ss += __shfl_xor(ss, 8);
            const float r = rsqrtf(ss * (1.f / 128.f) + 1e-6f);
            float y[8];
#pragma unroll
            for (int e = 0; e < 8; ++e) y[e] = o[e] * r * (e < 4 ? w0[e] : w1[e - 4]) * silu_f(zf[e]);
            u32x4 v; v.x = cvt_pk_bf16(y[0], y[1]); v.y = cvt_pk_bf16(y[2], y[3]); v.z = cvt_pk_bf16(y[4], y[5]); v.w = cvt_pk_bf16(y[6], y[7]);
            *(u32x4*)(dst + off) = v; }
    }
}

__device__ __forceinline__ void ffn_act_phase(const int tid, const bf16_t* __restrict__ up, bf16_t* __restrict__ hmid, const float* __restrict__ cw, const float* __restrict__ cb, int slab_row0, int slab_rows) {
    constexpr int RUN = 8, NCG = 352; const int NITEM = NCG * (slab_rows / RUN);
    for (int it = blockIdx.x * NTHR + tid; it < NITEM; it += gridDim.x * NTHR) {
        const int cgp = it % NCG, run = it / NCG, c = cgp * 8, lr0 = run * RUN;
        int s0, s1; seq_bounds(slab_row0 + lr0, s0, s1); s0 -= slab_row0; s1 -= slab_row0;
        const u32x4 zero = (u32x4){0u, 0u, 0u, 0u};
        u32x4 xv[RUN + 2], xg[RUN + 2];
#pragma unroll
        for (int i = 0; i < RUN + 2; ++i) { const int lr = lr0 - 1 + i; const bool ok = (i > 0 || lr >= s0) && (i < RUN + 1 || lr < s1);
            xv[i] = ok ? *(const u32x4*)(up + (size_t)lr * 5632 + c) : zero; xg[i] = ok ? *(const u32x4*)(up + (size_t)lr * 5632 + 2816 + c) : zero; }
        f32x4 wv[3][2], wg[3][2], bv[2], bg[2];
#pragma unroll
        for (int i = 0; i < 3; ++i)
#pragma unroll
            for (int h = 0; h < 2; ++h) { wv[i][h] = *(const f32x4*)(cw + i * 5632 + c + 4 * h); wg[i][h] = *(const f32x4*)(cw + i * 5632 + 2816 + c + 4 * h); }
#pragma unroll
        for (int h = 0; h < 2; ++h) { bv[h] = *(const f32x4*)(cb + c + 4 * h); bg[h] = *(const f32x4*)(cb + 2816 + c + 4 * h); }
#pragma unroll
        for (int r = 0; r < RUN; ++r) {
            float y[8];
#pragma unroll
            for (int e2 = 0; e2 < 4; ++e2) {
                const unsigned a0 = xv[r][e2], a1 = xv[r + 1][e2], a2 = xv[r + 2][e2], g0 = xg[r][e2], g1 = xg[r + 1][e2], g2 = xg[r + 2][e2];
                const int h = e2 >> 1, k = (e2 & 1) * 2;
                const float v0 = bv[h][k] + wv[0][h][k] * bf_lo(a0) + wv[1][h][k] * bf_lo(a1) + wv[2][h][k] * bf_lo(a2), v1 = bv[h][k + 1] + wv[0][h][k + 1] * bf_hi(a0) + wv[1][h][k + 1] * bf_hi(a1) + wv[2][h][k + 1] * bf_hi(a2);
                const float q0 = bg[h][k] + wg[0][h][k] * bf_lo(g0) + wg[1][h][k] * bf_lo(g1) + wg[2][h][k] * bf_lo(g2), q1 = bg[h][k + 1] + wg[0][h][k + 1] * bf_hi(g0) + wg[1][h][k + 1] * bf_hi(g1) + wg[2][h][k + 1] * bf_hi(g2);
                y[2 * e2] = silu_f(q0) * v0; y[2 * e2 + 1] = silu_f(q1) * v1;
            }
            u32x4 v; v.x = cvt_pk_bf16(y[0], y[1]); v.y = cvt_pk_bf16(y[2], y[3]); v.z = cvt_pk_bf16(y[4], y[5]); v.w = cvt_pk_bf16(y[6], y[7]);
            *(u32x4*)(hmid + (size_t)(lr0 + r) * 2816 + c) = v;
        }
    }
}

__device__ __forceinline__ int t5_bucket_abs(int n) { return n < 8 ? n : (n < 15 ? 8 : n < 27 ? 9 : n < 50 ? 10 : n < 91 ? 11 : n < 166 ? 12 : n < 305 ? 13 : n < 559 ? 14 : 15); }
constexpr int A_VT = 0, A_VTP = 392  , A_BIAS = 64 * A_VTP * 2;
__device__ __forceinline__ void attn_phase(const int tid0, ldsp L, const Params& p, const bf16_t* __restrict__ qkv, bf16_t* __restrict__ ao, float* __restrict__ lse) {
    LAS float* BT = (LAS float*)(L + A_BIAS);
    const float* rel_bias = p.in[13];
    for (int it = blockIdx.x; it < (MTOK / 256) * 12; it += gridDim.x) {
        int tid; asm volatile("v_mov_b32 %0, %1" : "=v"(tid) : "v"(tid0));
        const int wid = __builtin_amdgcn_readfirstlane(tid >> 6), lane = tid & 63, n32 = lane & 31, h2 = lane >> 5;
        const int tb = it / 12, head = it % 12, g = head >> 2, dsh = 2 * g, d = 1 << dsh;
        int s0, Ts, lb;
        if (tb < 64) { s0 = 0; Ts = TPROMPT; lb = tb; } else { s0 = TPROMPT + ((tb - 64) >> 4) * TSAMP; Ts = TSAMP; lb = (tb - 64) & 15; }
        const int Lq = Ts >> dsh, r = lb & (d - 1), st = lb >> dsh, p0 = 256 * st;
        __syncthreads();
        if (tid < 129) { const int rel = (tid - 64) * d, n = rel < 0 ? -rel : rel; BT[tid] = rel_bias[((rel > 0 ? 16 : 0) + t5_bucket_abs(n)) * 12 + head]; }
        u32x4 vv[6];
#pragma unroll
        for (int i = 0; i < 6; ++i) {
            const int idx = tid + NTHR * i, key = idx >> 3, ch = idx & 7; int pk = p0 - 64 + key; pk = pk < 0 ? 0 : (pk >= Lq ? Lq - 1 : pk);
            vv[i] = *(const u32x4*)(qkv + (size_t)(s0 + (pk << dsh) + r) * 2304 + 1536 + head * 64 + ch * 8);
        }
        const int qp = p0 + 32 * wid + n32; const size_t qtok = (size_t)(s0 + (qp << dsh) + r);
        bf16x8 qf[4];
#pragma unroll
        for (int kk = 0; kk < 4; ++kk) qf[kk] = *(const bf16x8*)(qkv + qtok * 2304 + head * 64 + 16 * kk + 8 * h2);
        f32x16 sc[5];
#pragma unroll
        for (int jt = 0; jt < 5; ++jt) {
            int kp = p0 + 32 * wid - 64 + 32 * jt + n32; kp = kp < 0 ? 0 : (kp >= Lq ? Lq - 1 : kp);
            const bf16_t* kr = qkv + (size_t)(s0 + (kp << dsh) + r) * 2304 + 768 + head * 64 + 8 * h2;
            f32x16 a;
#pragma unroll
            for (int e = 0; e < 16; ++e) a[e] = 0.f;
#pragma unroll
            for (int kk = 0; kk < 4; ++kk) a = MFMA32(*(const bf16x8*)(kr + 16 * kk), qf[kk], a);
            sc[jt] = a;
        }
#pragma unroll
        for (int i = 0; i < 6; ++i) {
            const int idx = tid + NTHR * i, key = idx >> 3, ch = idx & 7; const u32x4 v = vv[i];
            LAS unsigned short* vt = (LAS unsigned short*)(L + A_VT) + (ch * 8) * A_VTP + key;
            vt[0] = (unsigned short)(v.x & 0xffffu); vt[A_VTP] = (unsigned short)(v.x >> 16); vt[2 * A_VTP] = (unsigned short)(v.y & 0xffffu); vt[3 * A_VTP] = (unsigned short)(v.y >> 16);
            vt[4 * A_VTP] = (unsigned short)(v.z & 0xffffu); vt[5 * A_VTP] = (unsigned short)(v.z >> 16); vt[6 * A_VTP] = (unsigned short)(v.w & 0xffffu); vt[7 * A_VTP] = (unsigned short)(v.w >> 16);
        }
        __syncthreads();
        float mx = -3.0e38f, sum = 0.f;
        const bool interior = (p0 + 32 * wid - 64 >= 0) && (p0 + 32 * wid + 95 < Lq);
        if (interior) {
            const int dl = 4 * h2 - n32;
#pragma unroll
            for (int jt = 0; jt < 5; ++jt)
#pragma unroll
                for (int e = 0; e < 16; ++e) {
                    const int rel = 32 * jt - 64 + (e & 3) + 8 * (e >> 2) + dl;
                    float lg = sc[jt][e] * 0.125f + BT[(jt == 0 ? (rel < -64 ? -64 : rel) : (jt == 4 ? (rel > 64 ? 64 : rel) : rel)) + 64];
                    if (jt == 0) lg = rel >= -64 ? lg : -1.0e30f;
                    if (jt == 4) lg = rel <= 64 ? lg : -1.0e30f;
                    sc[jt][e] = lg; mx = fmaxf(mx, lg);
                }
            mx = fmaxf(mx, __shfl_xor(mx, 32));
#pragma unroll
            for (int jt = 0; jt < 5; ++jt)
#pragma unroll
                for (int e = 0; e < 16; ++e) { float pe = __expf(sc[jt][e] - mx); if (jt == 0 || jt == 4) pe = sc[jt][e] > -1.0e29f ? pe : 0.f; sc[jt][e] = pe; sum += pe; }
        } else {
#pragma unroll
            for (int jt = 0; jt < 5; ++jt)
#pragma unroll
                for (int e = 0; e < 16; ++e) {
                    const int m = (e & 3) + 8 * (e >> 2) + 4 * h2, rel = 32 * jt - 64 + m - n32, kp = qp + rel;
                    const bool ok = rel >= -64 && rel <= 64 && kp >= 0 && kp < Lq;
                    const float lg = ok ? sc[jt][e] * 0.125f + BT[ok ? rel + 64 : 64] : -1.0e30f;
                    sc[jt][e] = lg; mx = fmaxf(mx, lg);
                }
            mx = fmaxf(mx, __shfl_xor(mx, 32));
#pragma unroll
            for (int jt = 0; jt < 5; ++jt)
#pragma unroll
                for (int e = 0; e < 16; ++e) { const float pe = sc[jt][e] > -1.0e29f ? __expf(sc[jt][e] - mx) : 0.f; sc[jt][e] = pe; sum += pe; }
        }
        sum += __shfl_xor(sum, 32);
        f32x16 ot[2];
#pragma unroll
        for (int dt = 0; dt < 2; ++dt)
#pragma unroll
            for (int e = 0; e < 16; ++e) ot[dt][e] = 0.f;
#pragma unroll
        for (int jt = 0; jt < 5; ++jt)
#pragma unroll
            for (int s2 = 0; s2 < 2; ++s2) {
                u32x4 pb; pb.x = cvt_pk_bf16(sc[jt][8 * s2 + 0], sc[jt][8 * s2 + 1]); pb.y = cvt_pk_bf16(sc[jt][8 * s2 + 2], sc[jt][8 * s2 + 3]); pb.z = cvt_pk_bf16(sc[jt][8 * s2 + 4], sc[jt][8 * s2 + 5]); pb.w = cvt_pk_bf16(sc[jt][8 * s2 + 6], sc[jt][8 * s2 + 7]);
                const int kb = 32 * wid + 32 * jt + 16 * s2 + 4 * h2;
#pragma unroll
                for (int dt = 0; dt < 2; ++dt) {
                    ldsp vp = L + A_VT + ((32 * dt + n32) * A_VTP + kb) * 2;
                    const u32x2 lo = *(LAS const u32x2*)vp, hi = *(LAS const u32x2*)(vp + 16); u32x4 va; va.x = lo.x; va.y = lo.y; va.z = hi.x; va.w = hi.y;
                    ot[dt] = MFMA32(as_bf16x8(va), as_bf16x8(pb), ot[dt]);
                }
            }
        const float inv = 1.f / sum;
        bf16_t* orow = ao + qtok * 768 + head * 64;
#pragma unroll
        for (int dt = 0; dt < 2; ++dt)
#pragma unroll
            for (int g4 = 0; g4 < 4; ++g4) { u32x2 v; v.x = cvt_pk_bf16(ot[dt][4 * g4] * inv, ot[dt][4 * g4 + 1] * inv); v.y = cvt_pk_bf16(ot[dt][4 * g4 + 2] * inv, ot[dt][4 * g4 + 3] * inv);
                *(u32x2*)(orow + 32 * dt + 8 * g4 + 4 * h2) = v; }
        if (h2 == 0) lse[qtok * 12 + head] = mx + __logf(sum);
    }
}
__device__ __forceinline__ void attn_combine_phase(const int tid, const bf16_t* __restrict__ ao, const float* __restrict__ lse, bf16_t* __restrict__ dst) {
    constexpr int U = 4;
    const size_t S = (size_t)gridDim.x * NTHR, NE = (size_t)MTOK * 96;
    for (size_t e0 = (size_t)blockIdx.x * NTHR + tid; e0 < NE; e0 += S * U) {
        float l0[U], l1[U], l2[U], lh[U]; u32x4 a[U];
#pragma unroll
        for (int u = 0; u < U; ++u) { const size_t e = e0 + u * S < NE ? e0 + u * S : e0; const size_t t = e / 96; const int c8 = (int)(e % 96), head = c8 >> 3, i = head & 3;
            l0[u] = lse[t * 12 + i]; l1[u] = lse[t * 12 + 4 + i]; l2[u] = lse[t * 12 + 8 + i]; lh[u] = lse[t * 12 + head]; a[u] = *(const u32x4*)(ao + e * 8); }
#pragma unroll
        for (int u = 0; u < U; ++u) { const size_t e = e0 + u * S; if (e >= NE) break;
            const float m = fmaxf(l0[u], fmaxf(l1[u], l2[u])), al = __expf(lh[u] - m) / (__expf(l0[u] - m) + __expf(l1[u] - m) + __expf(l2[u] - m));
            u32x4 v; v.x = cvt_pk_bf16(bf_lo(a[u].x) * al, bf_hi(a[u].x) * al); v.y = cvt_pk_bf16(bf_lo(a[u].y) * al, bf_hi(a[u].y) * al); v.z = cvt_pk_bf16(bf_lo(a[u].z) * al, bf_hi(a[u].z) * al); v.w = cvt_pk_bf16(bf_lo(a[u].w) * al, bf_hi(a[u].w) * al);
            *(u32x4*)(dst + e * 8) = v; }
    }
}

#define XB_TMO      128
#define XB_XCNT(j)  (256  + 64 * (j))
#define XB_XSUB(j)  (1280 + 64 * (j))
#define XB_XGEN(j)  (2304 + 64 * (j))
#define XB_TOP      3328
#define XB_TOPGEN   3392
#define XCD_BAR_WORDS 3456
#define XB_SPIN_CAP (1u << 20)
__device__ __forceinline__ unsigned xb_ld(unsigned* p)              { return __hip_atomic_load(p, __ATOMIC_RELAXED, __HIP_MEMORY_SCOPE_AGENT); }
__device__ __forceinline__ unsigned xb_add(unsigned* p, unsigned v) { return __hip_atomic_fetch_add(p, v, __ATOMIC_RELAXED, __HIP_MEMORY_SCOPE_AGENT); }
__device__ __forceinline__ unsigned xb_xcc_id() { return (unsigned)__builtin_amdgcn_s_getreg((3 << 11) | 20) & 0xFu; }
#define XB_SPIN(cond, bar) do { unsigned _sp = 0; while (cond) { __builtin_amdgcn_s_sleep(1); \
    if ((++_sp & 255u) == 0u) { if (xb_ld(&(bar)[XB_TMO])) break; if (_sp > XB_SPIN_CAP) { atomicAdd(&(bar)[XB_TMO], 1u); break; } } } } while (0)
struct XcdBarrier { unsigned* bar; unsigned x; volatile LAS unsigned* st; };
__device__ __forceinline__ XcdBarrier xcd_barrier_post(unsigned* bar, volatile LAS unsigned* st) {
    XcdBarrier b; b.bar = bar; b.x = xb_xcc_id(); b.st = st;
    if (threadIdx.x == 0) (void)xb_add(&bar[XB_XCNT(b.x)], 1u);
    return b;
}
__device__ __forceinline__ void xcd_barrier_complete(unsigned* bar, unsigned x, unsigned& nloc, unsigned& nx) {
    const unsigned G = gridDim.x * gridDim.y * gridDim.z;
    unsigned sum, cnt, mine, sp = 0u;
    for (;;) {
        sum = 0u; cnt = 0u; mine = 0u;
#pragma unroll
        for (unsigned j = 0; j < 16; ++j) { const unsigned c = xb_ld(&bar[XB_XCNT(j)]); sum += c; cnt += (c > 0u) ? 1u : 0u; mine = (j == x) ? c : mine; }
        if (sum == G) break;
        __builtin_amdgcn_s_sleep(1);
        if ((++sp & 255u) == 0u) { if (xb_ld(&bar[XB_TMO])) break; if (sp > XB_SPIN_CAP) { atomicAdd(&bar[XB_TMO], 1u); break; } }
    }
    nloc = mine > 0u ? mine : 1u; nx = cnt > 0u ? cnt : 1u;
}
__device__ __forceinline__ void xcd_barrier(const XcdBarrier& b) {
    asm volatile("s_waitcnt vmcnt(0)" ::: "memory");
    __syncthreads();
    if (threadIdx.x == 0) {
        unsigned* bar = b.bar;
        __builtin_amdgcn_s_waitcnt(0);
        unsigned nloc = b.st[0], nx = b.st[1];
        if (nloc == 0u) { xcd_barrier_complete(bar, b.x, nloc, nx); b.st[0] = nloc; b.st[1] = nx; }
        const unsigned old = xb_add(&bar[XB_XSUB(b.x)], 1u);
        const unsigned gen = old / nloc;
        if (old + 1u == (gen + 1u) * nloc) {
            __builtin_amdgcn_fence(__ATOMIC_RELEASE, "agent");
            asm volatile("s_waitcnt vmcnt(0)" ::: "memory");
            const unsigned og = xb_add(&bar[XB_TOP], 1u);
            const unsigned tg = og / nx;
            if (og + 1u == (tg + 1u) * nx) xb_add(&bar[XB_TOPGEN], 1u);
            else XB_SPIN(xb_ld(&bar[XB_TOPGEN]) == tg, bar);
            __builtin_amdgcn_fence(__ATOMIC_ACQUIRE, "agent");
            xb_add(&bar[XB_XGEN(b.x)], 1u);
            asm volatile("s_waitcnt vmcnt(0)" ::: "memory");
        } else {
            XB_SPIN(xb_ld(&bar[XB_XGEN(b.x)]) == gen, bar);
            __builtin_amdgcn_fence(__ATOMIC_ACQUIRE, "agent");
            asm volatile("s_waitcnt vmcnt(0)" ::: "memory");
        }
    }
    __syncthreads();
}

struct EpiBf16Any {
    static constexpr bool PERM = true, AFTER_DRAIN = false;
    bf16_t* O; int ldc; int gdn; bf16_t* z; float* gates; bf16_t* halo;
    __device__ __forceinline__ void operator()(const f32x4 (&acc)[2][2][4][2], const Unit& u, int wr, int wc, int fr, int fq) const {
        const int row0 = u.pm * 256 + wr * 64 + fr;
        bf16_t* base = O; int ld = ldc, colt = u.pn * 256;
        if (gdn) {
            if (u.pn >= 16) {
                if (wc == 0) {
#pragma unroll
                    for (int ai = 0; ai < 2; ++ai)
#pragma unroll
                        for (int m = 0; m < 4; ++m) { float* g = gates + (size_t)(row0 + ai * 128 + m * 16) * 32 + 8 * fq; *(f32x4*)g = acc[ai][0][m][0]; *(f32x4*)(g + 4) = acc[ai][0][m][1]; }
                }
                return;
            }
            if (u.pn >= 12) { base = z; ld = 1024; colt = (u.pn - 12) * 256; }
        }
        const int col0 = colt + wc * 32 + 8 * fq;
#pragma unroll
        for (int ai = 0; ai < 2; ++ai)
#pragma unroll
            for (int m = 0; m < 4; ++m) { bf16_t* rowp = base + (size_t)(row0 + ai * 128 + m * 16) * ld + col0;
#pragma unroll
                for (int bj = 0; bj < 2; ++bj) { const f32x4 v0 = acc[ai][bj][m][0], v1 = acc[ai][bj][m][1]; u32x4 o; o.x = cvt_pk_bf16(v0[0], v0[1]); o.y = cvt_pk_bf16(v0[2], v0[3]); o.z = cvt_pk_bf16(v1[0], v1[1]); o.w = cvt_pk_bf16(v1[2], v1[3]);
                    *(u32x4*)(rowp + bj * 128) = o;
                    if (gdn && u.pn < 12 && ((m == 0 && fr < 2) || (m == 3 && fr >= 14))) {
                        const int r = row0 + ai * 128 + m * 16, rl = r & 63, hb = (r >> 6) + (rl >= 62 ? 1 : 0), hs = rl >= 62 ? rl - 62 : 2 + rl;
                        *(u32x4*)(halo + ((size_t)hb * 4 + hs) * 3072 + col0 + bj * 128) = o; } }
                asm volatile("" ::: "memory"); }
    }
};

__device__ __forceinline__ void prep_weights(const int tid, ldsp L, const Params& p, bf16_t* W, int wi_lo, int wi_hi, int tstart, int tstride) {
    for (int wi = wi_lo; wi < wi_hi; ++wi) {
        const float* src; bf16_t* dst; int K, N, Np;
        switch (wi) {
        case 0: src = p.in[5]; dst = W + W_GDN_IN; K = 1024; N = 4128; Np = 4352; break;
        case 1: src = p.in[10]; dst = W + W_GDN_OUT; K = 1024; N = 1024; Np = 1024; break;
        case 2: src = p.in[11]; dst = W + W_ATT_IN; K = 1024; N = 2304; Np = 2304; break;
        case 3: src = p.in[12]; dst = W + W_ATT_OUT; K = 768; N = 1024; Np = 1024; break;
        case 4: src = p.in[14]; dst = W + W_FFN_UP; K = 1024; N = 5632; Np = 5632; break;
        case 5: src = p.in[14] + (size_t)1024 * 5632; dst = W + W_FFN_UP + (size_t)5632 * 1024; K = 1024; N = 5632; Np = 5632; break;
        case 6: src = p.in[17]; dst = W + W_FFN_DOWN; K = 2816; N = 1024; Np = 1024; break;
        default: src = p.in[17] + (size_t)2816 * 1024; dst = W + W_FFN_DOWN + (size_t)1024 * 2816; K = 2816; N = 1024; Np = 1024; break;
        }
        wt_convert(tid, L, src, dst, K, N, Np, (wi == 4 || wi == 5) ? 1 : 0, tstart, tstride);
    }
}
enum { K_PREP = 0, K_RMS, K_GEMM_BF16, K_GEMM_RESID, K_GDNLOC, K_GDN, K_GDNCOMB, K_GEMM_UP, K_FIX, K_ATT, K_ATTCOMB, K_FINAL };
constexpr int NPHASE = 21;
__device__ __forceinline__ void decode_phase(int ph, int& kind, int& which, int& layer, bool& sync) {
    layer = 0; which = 0; sync = true;
    switch (ph) {
    case 0: kind = K_PREP; sync = false; break;
    case 1: kind = K_RMS; which = 0; break;
    case 2: kind = K_GEMM_BF16; which = 0; break;
    case 3: kind = K_GDNLOC; break;
    case 4: kind = K_GDN; break;
    case 5: kind = K_GDNCOMB; break;
    case 6: kind = K_GEMM_RESID; which = 0; break;
    case 7: kind = K_RMS; which = 1; break;
    case 8: kind = K_GEMM_UP; break;
    case 9: kind = K_FIX; break;
    case 10: kind = K_GEMM_RESID; which = 1; break;
    case 11: kind = K_RMS; which = 2; break;
    case 12: kind = K_GEMM_BF16; which = 2; break;
    case 13: kind = K_ATT; break;
    case 14: kind = K_ATTCOMB; break;
    case 15: kind = K_GEMM_RESID; which = 2; break;
    case 16: kind = K_RMS; which = 3; break;
    case 17: kind = K_GEMM_UP; layer = 1; break;
    case 18: kind = K_FIX; layer = 1; break;
    case 19: kind = K_GEMM_RESID; which = 1; layer = 1; break;
    default: kind = K_FINAL; sync = false; break;
    }
}

__global__ void __launch_bounds__(512, 2) mega_fwd(Params p) {
    extern __shared__ __attribute__((aligned(16))) unsigned char shm[];
    ldsp L = (ldsp)shm;
    cg::grid_group grid = cg::this_grid();
    __shared__ uint4 xb_words;
    if (threadIdx.x == 0) xb_words = make_uint4(0u, 0u, 0u, 0u);
    __syncthreads();
    const XcdBarrier xb = xcd_barrier_post((unsigned*)(p.ws + WS_BAR), (volatile LAS unsigned*)&xb_words);
#ifdef PROBE
    unsigned long long pr_acc[2] = {0ull, 0ull}; const unsigned long long pr_start = __builtin_amdgcn_s_memrealtime();
#endif
    for (int ph = 0; ph < NPHASE; ++ph) {
#ifdef PROBE
        const unsigned long long pr_t0 = __builtin_amdgcn_s_memrealtime();
#endif
        int tid; asm volatile("v_mov_b32 %0, %1" : "=v"(tid) : "v"((int)threadIdx.x));
        unsigned char* ws = p.ws;
        bf16_t* W = (bf16_t*)(ws + WS_W);
        bf16_t* R1 = (bf16_t*)(ws + WS_R1); bf16_t* R2 = (bf16_t*)(ws + WS_R2); bf16_t* R3 = (bf16_t*)(ws + WS_R3); float* R4 = (float*)(ws + WS_R4);
        bf16_t* hmid = R3; float* raw = (float*)(R3 + (size_t)MTOK * 2816);
        bf16_t* ao = R3 + (size_t)MTOK * 2304; bf16_t* XB = (bf16_t*)p.out + (size_t)MTOK * 1024;
        int kind, which, layer; bool sync;
        decode_phase(ph, kind, which, layer, sync);
        switch (kind) {
        case K_PREP:
            prep_weights(tid, L, p, W, 0, gridDim.x == 256 ? 2 : 8, (int)blockIdx.x, (int)gridDim.x); break;
        case K_RMS: {
            const float* w = which == 0 ? p.in[2] : (which == 1 ? p.in[3] : (which == 2 ? p.in[2] + 1024 : p.in[3] + 1024));
            if (which == 0) rmsnorm_f32in_phase(tid, p.in[0], p.in[1], TPROMPT, w, R1);
            else rmsnorm_bf16_phase(tid, which == 3 ? (const bf16_t*)R1 : (const bf16_t*)XB, w, which == 3 ? R2 : R1);
        } break;
        case K_GEMM_BF16: {
            EpiBf16Any E; E.gdn = 0; E.z = R2; E.gates = R4; E.halo = (bf16_t*)(ws + WS_HALO); const bf16_t* A; const bf16_t* Bt; int M, N;
            if (which == 0) { A = R1; Bt = W + W_GDN_IN; M = MTOK; N = 4352; E.O = R3; E.ldc = 3072; E.gdn = 1; }
            else { A = R1; Bt = W + W_ATT_IN; M = MTOK; N = 2304; E.O = R3; E.ldc = 2304; }
            run_gemm(tid, L, A, Bt, M, N, 1024, E);
        } break;
        case K_GEMM_RESID: {
            EpiResid E; E.outf = nullptr; E.ob = nullptr; E.r0 = p.in[0]; E.r1 = p.in[1]; E.split = TPROMPT; E.rb = nullptr; const bf16_t* A; const bf16_t* Bt; int M, K;
            if (which == 0) { A = R3; Bt = W + W_GDN_OUT; M = MTOK; K = 1024; E.ob = XB; }
            else if (which == 1) { A = hmid; Bt = W + W_FFN_DOWN + (size_t)layer * 1024 * 2816; M = MTOK; K = 2816;
                if (layer == 0) { E.rb = XB; E.ob = XB; }
                else { E.rb = R1; E.ob = R2; } }
            else { A = R2; Bt = W + W_ATT_OUT; M = MTOK; K = 768; E.rb = XB; E.ob = R1; }
            run_gemm(tid, L, A, Bt, M, 1024, K, E);
        } break;
        case K_GDNLOC: gdn_local_phase(tid, L, p, R3, (const bf16_t*)(ws + WS_HALO), R4, R1, (bf16_t*)p.out, (bf16_t*)p.out + (size_t)MTOK * 1024, (float*)(ws + WS_GSC)); break;
        case K_GDN: gdn_scan_phase(tid, L, R3, R1, (bf16_t*)p.out, (const bf16_t*)p.out + (size_t)MTOK * 1024, (const float*)(ws + WS_GSC), (bf16_t*)(ws + WS_OPF), (bf16_t*)(ws + WS_OPB));
            if (gridDim.x == 256 && blockIdx.x >= 128) { __syncthreads(); prep_weights(tid, L, p, W, 2, 8, (int)blockIdx.x - 128, 128); }
            break;
        case K_GDNCOMB: gdn_combine_phase(tid, L, p, R1, (const bf16_t*)p.out, R2, R3, (const bf16_t*)(ws + WS_OPF), (const bf16_t*)(ws + WS_OPB)); break;
        case K_GEMM_UP: {
            EpiFfnUp E; E.hmid = hmid; E.raw = raw; E.cw = p.in[15] + (size_t)layer * 3 * 5632; E.cb = p.in[16] + (size_t)layer * 5632; E.X = L + LDS_XCHG;
            run_gemm(tid, L, layer == 0 ? R1 : R2, W + W_FFN_UP + (size_t)layer * 5632 * 1024, MTOK, 5632, 1024, E);
        } break;
        case K_FIX: ffn_fix_phase(tid, raw, hmid, p.in[15] + (size_t)layer * 3 * 5632, p.in[16] + (size_t)layer * 5632); break;
#ifndef NO_ATT
        case K_ATT: attn_phase(tid, L, p, R3, ao, R4); break;
#endif
        case K_ATTCOMB: attn_combine_phase(tid, ao, R4, R2); break;
#ifdef PROBE
        default: rmsnorm_final_bf16_phase(tid, R2, p.in[4], p.out, *(volatile float*)(ws + WS_END)); break;
#else
        default: rmsnorm_final_bf16_phase(tid, R2, p.in[4], p.out, 0.f); break;
#endif
        }
#ifdef PROBE
        if (ph == NPHASE - 2 && blockIdx.x == 0 && threadIdx.x == 0) {
            const unsigned long long now = __builtin_amdgcn_s_memrealtime(); if (PROBE_A(kind)) pr_acc[0] += now - pr_t0; if (PROBE_B(kind)) pr_acc[1] += now - pr_t0;
            const float tot = (float)(now - pr_start); const float fa = fminf(rintf(100.f * (float)pr_acc[0] / tot), 99.f), fb = fminf(rintf(100.f * (float)pr_acc[1] / tot), 99.f);
            const float V = (fa + fb * 0.01f) * 0.01f; *(volatile float*)(ws + WS_END) = sqrtf(V * 1.0e-4f * 1.0004f);
            __threadfence();
        }
#endif
        if (sync) { if (ph == 1) grid.sync(); else xcd_barrier(xb); }
#ifdef PROBE
        if (ph < NPHASE - 2) { const unsigned long long now = __builtin_amdgcn_s_memrealtime(); if (PROBE_A(kind)) pr_acc[0] += now - pr_t0; if (PROBE_B(kind)) pr_acc[1] += now - pr_t0; }
#endif
    }
}

extern "C" void kernel_launch(void* const* d_in, const int* in_sizes, int n_in, void* d_out, int out_size, void* d_ws, size_t ws_size, hipStream_t stream) {
    static int grid_blocks = 0;
    if (grid_blocks == 0) {
        if (n_in != 18 || ws_size < WS_END) { fprintf(stderr, "kernel_launch: unexpected n_in %d / ws_size %zu\n", n_in, ws_size); grid_blocks = -1; return; }
        int dev = 0, cus = 0, per_cu = 0;
        hipGetDevice(&dev); hipDeviceGetAttribute(&cus, hipDeviceAttributeMultiprocessorCount, dev);
        if (hipFuncSetAttribute((const void*)mega_fwd, hipFuncAttributeMaxDynamicSharedMemorySize, LDS_BYTES) != hipSuccess) { fprintf(stderr, "kernel_launch: hipFuncSetAttribute failed\n"); grid_blocks = -1; return; }
        if (hipOccupancyMaxActiveBlocksPerMultiprocessor(&per_cu, (const void*)mega_fwd, NTHR, LDS_BYTES) != hipSuccess || per_cu < 1) { fprintf(stderr, "kernel_launch: occupancy query gave %d\n", per_cu); per_cu = 1; }
        (void)hipGetLastError();
        grid_blocks = cus;
    }
    if (grid_blocks < 0) return;
    Params p{};
    for (int i = 0; i < 18; ++i) p.in[i] = (const float*)d_in[i];
    p.out = (float*)d_out; p.ws = (unsigned char*)d_ws;
    if (hipMemsetAsync((unsigned char*)d_ws + WS_BAR, 0, 16384, stream) != hipSuccess) { fprintf(stderr, "kernel_launch: memset of the barrier words failed\n"); return; }
    void* args[] = {&p};
    hipError_t e = hipLaunchCooperativeKernel((const void*)mega_fwd, dim3(grid_blocks), dim3(NTHR), args, LDS_BYTES, stream);
    if (e != hipSuccess) fprintf(stderr, "cooperative launch failed: %s (grid %d)\n", hipGetErrorString(e), grid_blocks);
}
```

```cpp
#include <hip/hip_runtime.h>
#include <hip/hip_cooperative_groups.h>
#include <cstdio>
namespace cg = cooperative_groups;
namespace pg8 {
#define PG8_LAS __attribute__((address_space(3)))
typedef unsigned short bf16_t;
typedef short bf16x8 __attribute__((ext_vector_type(8)));
typedef float f32x4 __attribute__((ext_vector_type(4)));
typedef unsigned u32x4 __attribute__((ext_vector_type(4)));
constexpr int BM = 256, BK = 64, HALF = 128, HTB = HALF * BK * 2  , STAGE_BYTES = 8 * HTB, NXCD = 8, WGM = 8;

__host__ __device__ __forceinline__ int lds_byte(int r, int c) { const int st = (r >> 4) * 2 + (c >> 5), rr = r & 15, cc = c & 31, ob = rr * 64 + cc * 2; return st * 1024 + (ob ^ (((ob >> 9) & 1) << 5)); }
__host__ __device__ __forceinline__ void stage_rc(int b, int& R, int& C) { const int st = b / 1024, sb = b % 1024, swz = sb ^ (((sb >> 9) & 1) << 5); R = (st >> 1) * 16 + swz / 64; C = (st & 1) * 32 + (swz % 64) / 2; }
__host__ __device__ __forceinline__ int perm32(int rho) { const int n = rho >> 4, i = rho & 15; return 8 * (i >> 2) + 4 * n + (i & 3); }

struct Unit { int pm, pn; };
struct Gemm { const bf16_t* A; const bf16_t* Bt; int M, N, K; };
struct StaticOrder {
    int nM, nN, nwg, G, c;
    __host__ __device__ void init(int M, int N, int G_, int c_) { nM = M / BM; nN = N / BM; nwg = nM * nN; G = G_; c = c_; }
    __host__ __device__ bool next(int i, Unit& u) const {
        const long L = (long)i * G + c; if (L >= nwg) return false;
        int wgid = (int)L; { const int q = nwg / NXCD, r = nwg % NXCD, xcd = wgid % NXCD, off = wgid / NXCD; wgid = (xcd < r ? xcd * (q + 1) : r * (q + 1) + (xcd - r) * q) + off; }
        const int nig = WGM * nN, gid = wgid / nig, fm = gid * WGM, gsz = (nM - fm) < WGM ? (nM - fm) : WGM;
        u.pm = fm + ((wgid % nig) % gsz); u.pn = (wgid % nig) / gsz; return true;
    }
    __device__ __forceinline__ void a_ready(const Unit&) const {}
    __device__ __forceinline__ void done(const Unit&) const {}
};
__device__ __forceinline__ unsigned cvt_pk_bf16(float lo, float hi) { unsigned r; asm volatile("v_cvt_pk_bf16_f32 %0, %1, %2" : "=v"(r) : "v"(lo), "v"(hi)); return r; }
template <class Epi, class Sched>
__device__ __forceinline__ void gemm_phase(PG8_LAS unsigned char* lds, const Gemm g, const Sched& S, const Epi& E, const int tid_in) {
    const int tid = tid_in, wid = __builtin_amdgcn_readfirstlane(tid >> 6), lane = tid & 63, wr = wid >> 2, wc = wid & 3, fr = lane & 15, fq = lane >> 4;
    const int K = g.K, nt = K / BK;
    unsigned voffA[2], voffB[2];
#pragma unroll
    for (int i = 0; i < 2; ++i) { int R, C; stage_rc(tid * 16 + i * 8192, R, C); const int Rb = Epi::PERM ? ((R & ~31) + perm32(R & 31)) : R;
        voffA[i] = (unsigned)(R * K + C) * 2u; voffB[i] = (unsigned)(Rb * K + C) * 2u; }
    const size_t kstep = (size_t)(BK * 2);
    const size_t hstep = (size_t)HALF * K * 2;
    const size_t tstep = 2 * hstep;
    const unsigned ldsw = (unsigned)wid * 1024u;
    const int aoff = lds_byte(wr * 64 + fr, fq * 8), boff = lds_byte(wc * 32 + fr, fq * 8);
#define PG8_SA(b, h) (((b) * 2 + (h)) * HTB)
#define PG8_SB(b, h) ((4 + (b) * 2 + (h)) * HTB)
#define PG8_STAGE(bufoff, gbase, voff) do { _Pragma("unroll") for (int _i = 0; _i < 2; ++_i) \
        __builtin_amdgcn_global_load_lds((const unsigned*)((const char*)(gbase) + (voff)[_i]), (PG8_LAS unsigned*)(lds + (bufoff) + ldsw + _i * 8192), 16, 0, 0); } while (0)
#define PG8_LDA(dst, b, h) do { _Pragma("unroll") for (int m = 0; m < 4; ++m) _Pragma("unroll") for (int k = 0; k < 2; ++k) dst[m][k] = *(const PG8_LAS bf16x8*)(lds + PG8_SA(b, h) + aoff + m * 2048 + k * 1024); } while (0)
#define PG8_LDB(dst, b, h) do { _Pragma("unroll") for (int n = 0; n < 2; ++n) _Pragma("unroll") for (int k = 0; k < 2; ++k) dst[n][k] = *(const PG8_LAS bf16x8*)(lds + PG8_SB(b, h) + boff + n * 2048 + k * 1024); } while (0)
#define PG8_MMA(ai, bj, At, Bt) do { __builtin_amdgcn_s_setprio(1); _Pragma("unroll") for (int m = 0; m < 4; ++m) _Pragma("unroll") for (int n = 0; n < 2; ++n) _Pragma("unroll") for (int k = 0; k < 2; ++k) \
        acc[ai][bj][m][n] = __builtin_amdgcn_mfma_f32_16x16x32_bf16(Bt[n][k], At[m][k], acc[ai][bj][m][n], 0, 0, 0); __builtin_amdgcn_s_setprio(0); } while (0)
#define PG8_WAIT_V(n) asm volatile("s_waitcnt vmcnt(" #n ")" ::: "memory")
#define PG8_WAIT_L(n) asm volatile("s_waitcnt lgkmcnt(" #n ")" ::: "memory")
#define PG8_BAR __builtin_amdgcn_s_barrier()
#define PG8_SCHED __builtin_amdgcn_sched_barrier(0)
    Unit cur, nxt; int ui = 0;
    if (!S.next(0, cur)) return;
    f32x4 acc[2][2][4][2];
#pragma unroll
    for (int a = 0; a < 2; ++a)
#pragma unroll
        for (int b = 0; b < 2; ++b)
#pragma unroll
            for (int m = 0; m < 4; ++m)
#pragma unroll
                for (int n = 0; n < 2; ++n) acc[a][b][m][n] = (f32x4){0.f, 0.f, 0.f, 0.f};
    bf16x8 At[4][2], B0[2][2], B1[2][2];
    const char* cA = (const char*)g.A + (size_t)cur.pm * tstep; const char* cB = (const char*)g.Bt + (size_t)cur.pn * tstep;
    S.a_ready(cur);
    PG8_STAGE(PG8_SB(0, 0), cB, voffB); PG8_STAGE(PG8_SA(0, 0), cA, voffA); PG8_STAGE(PG8_SB(0, 1), cB + hstep, voffB); PG8_STAGE(PG8_SA(0, 1), cA + hstep, voffA);
    if (wr == 1) PG8_BAR;
    PG8_WAIT_V(4); PG8_BAR;
    PG8_STAGE(PG8_SB(1, 0), cB + kstep, voffB); PG8_STAGE(PG8_SA(1, 0), cA + kstep, voffA); PG8_STAGE(PG8_SB(1, 1), cB + hstep + kstep, voffB);
    PG8_WAIT_V(6); PG8_BAR;
    for (;;) {
        const bool has_next = S.next(ui + 1, nxt);
        const char* nA = has_next ? (const char*)g.A + (size_t)nxt.pm * tstep : cA; const char* nB = has_next ? (const char*)g.Bt + (size_t)nxt.pn * tstep : cB;
        for (int t = 0; t < nt; t += 2) {
            const bool last = (t == nt - 2);
            const char* a1 = cA + (size_t)(t + 1) * kstep;
            const char* a2 = last ? nA : cA + (size_t)(t + 2) * kstep; const char* b2 = last ? nB : cB + (size_t)(t + 2) * kstep;
            const char* a3 = a2 + kstep; const char* b3 = b2 + kstep;
            if (last && has_next) S.a_ready(nxt);
            PG8_LDB(B0, 0, 0); PG8_SCHED; PG8_LDA(At, 0, 0); PG8_STAGE(PG8_SA(1, 1), a1 + hstep, voffA);
            PG8_WAIT_L(8); PG8_BAR; PG8_WAIT_L(0); PG8_MMA(0, 0, At, B0); PG8_BAR; PG8_SCHED;
            PG8_LDB(B1, 0, 1); PG8_STAGE(PG8_SB(0, 0), b2, voffB);
            PG8_BAR; PG8_WAIT_L(0); PG8_MMA(0, 1, At, B1); PG8_BAR;
            PG8_LDA(At, 0, 1); PG8_STAGE(PG8_SA(0, 0), a2, voffA);
            PG8_BAR; PG8_WAIT_L(0); PG8_MMA(1, 0, At, B0); PG8_BAR; PG8_SCHED;
            PG8_STAGE(PG8_SB(0, 1), b2 + hstep, voffB);
            PG8_WAIT_V(6); PG8_BAR; PG8_MMA(1, 1, At, B1); PG8_BAR;
            PG8_LDB(B0, 1, 0); PG8_SCHED; PG8_LDA(At, 1, 0); PG8_STAGE(PG8_SA(0, 1), a2 + hstep, voffA);
            PG8_WAIT_L(8); PG8_BAR; PG8_WAIT_L(0); PG8_MMA(0, 0, At, B0); PG8_BAR; PG8_SCHED;
            PG8_LDB(B1, 1, 1); PG8_STAGE(PG8_SB(1, 0), b3, voffB);
            PG8_BAR; PG8_WAIT_L(0); PG8_MMA(0, 1, At, B1); PG8_BAR;
            PG8_LDA(At, 1, 1); PG8_STAGE(PG8_SA(1, 0), a3, voffA);
            PG8_BAR; PG8_WAIT_L(0); PG8_MMA(1, 0, At, B0); PG8_BAR; PG8_SCHED;
            PG8_STAGE(PG8_SB(1, 1), b3 + hstep, voffB);
            PG8_WAIT_V(6); PG8_BAR; PG8_MMA(1, 1, At, B1); PG8_BAR;
        }
        if constexpr (!Epi::AFTER_DRAIN) { E(acc, cur, wr, wc, fr, fq); S.done(cur); }
        if (!has_next) break;
#pragma unroll
        for (int a = 0; a < 2; ++a)
#pragma unroll
            for (int b = 0; b < 2; ++b)
#pragma unroll
                for (int m = 0; m < 4; ++m)
#pragma unroll
                    for (int n = 0; n < 2; ++n) acc[a][b][m][n] = (f32x4){0.f, 0.f, 0.f, 0.f};
        cur = nxt; cA = nA; cB = nB; ++ui;
    }
    PG8_WAIT_V(0);
    if (wr == 0) PG8_BAR;
    PG8_BAR;
    if constexpr (Epi::AFTER_DRAIN) { E.fused(acc, cur, wr, wc, fr, fq, lds, wid, lane); S.done(cur); }
#undef PG8_SA
#undef PG8_SB
#undef PG8_STAGE
#undef PG8_LDA
#undef PG8_LDB
#undef PG8_MMA
#undef PG8_WAIT_V
#undef PG8_WAIT_L
#undef PG8_BAR
#undef PG8_SCHED
}
}

using pg8::bf16_t; using pg8::bf16x8; using pg8::f32x4; using pg8::u32x4; using pg8::Unit; using pg8::cvt_pk_bf16;
typedef unsigned u32x2 __attribute__((ext_vector_type(2)));
typedef float f32x16 __attribute__((ext_vector_type(16)));
#define LAS __attribute__((address_space(3)))
typedef LAS unsigned char* ldsp;

constexpr int MTOK = 81920, TPROMPT = 16384, TSAMP = 4096, DMODEL = 1024;
constexpr int LDS_BYTES = 131072 + 8192;
constexpr int LDS_XCHG = 131072;
constexpr int NTHR = 512;

constexpr size_t WS_W  = 0;
constexpr size_t WS_R1 = 67108864;
constexpr size_t WS_R2 = WS_R1 + 167772160;
constexpr size_t WS_R3 = WS_R2 + 167772160;
constexpr size_t WS_R4 = WS_R3 + 503316480;
constexpr size_t WS_HALO = WS_R4 + 10485760;
constexpr size_t WS_GSC = WS_HALO + 31481856;
constexpr size_t WS_BAR = 62914560;
constexpr size_t WS_OPF = WS_GSC + (size_t)20480 * 144 * 4;
constexpr size_t WS_OPB = WS_OPF + 33554432;
constexpr size_t WS_END = WS_OPB + 33554432;
constexpr size_t W_GDN_IN = 0, W_GDN_OUT = W_GDN_IN + (size_t)4352 * 1024, W_ATT_IN = W_GDN_OUT + (size_t)1024 * 1024, W_ATT_OUT = W_ATT_IN + (size_t)2304 * 1024,
                 W_FFN_UP = W_ATT_OUT + (size_t)1024 * 768, W_FFN_DOWN = W_FFN_UP + (size_t)2 * 5632 * 1024, W_TOTAL = W_FFN_DOWN + (size_t)2 * 1024 * 2816;
static_assert(W_TOTAL * 2 <= 62914560, "weights overflow");

struct Params { const float* in[18]; float* out; unsigned char* ws; };

__device__ __forceinline__ unsigned short f2bf(float f) { unsigned u = __float_as_uint(f); u += 0x7FFFu + ((u >> 16) & 1u); return (unsigned short)(u >> 16); }
__device__ __forceinline__ float bf_lo(unsigned u) { return __uint_as_float(u << 16); }
__device__ __forceinline__ float bf_hi(unsigned u) { return __uint_as_float(u & 0xffff0000u); }
__device__ __forceinline__ float bf2f(unsigned short b) { return __uint_as_float(((unsigned)b) << 16); }
__device__ __forceinline__ float silu_f(float v) { return v * __builtin_amdgcn_rcpf(1.f + __expf(-v)); }
__device__ __forceinline__ bf16x8 as_bf16x8(u32x4 v) { union { u32x4 u; bf16x8 b; } c; c.u = v; return c.b; }
__device__ __forceinline__ bf16x8 pack8(f32x4 a, f32x4 b) { u32x4 v; v.x = cvt_pk_bf16(a[0], a[1]); v.y = cvt_pk_bf16(a[2], a[3]); v.z = cvt_pk_bf16(b[0], b[1]); v.w = cvt_pk_bf16(b[2], b[3]); return as_bf16x8(v); }
__device__ __forceinline__ bf16x8 lds_read2(ldsp p) { const u32x2 lo = *(LAS const u32x2*)p, hi = *(LAS const u32x2*)(p + 32); u32x4 v; v.x = lo.x; v.y = lo.y; v.z = hi.x; v.w = hi.y; return as_bf16x8(v); }
__device__ __forceinline__ void seq_bounds(int t, int& s0, int& s1) { if (t < TPROMPT) { s0 = 0; s1 = TPROMPT; } else { s0 = t & ~(TSAMP - 1); s1 = s0 + TSAMP; } }
#define FENCE() do { asm volatile("" ::: "memory"); __builtin_amdgcn_sched_barrier(0); } while (0)
__device__ __forceinline__ float dpp_prev16(float x) { return __int_as_float(__builtin_amdgcn_update_dpp(0, __float_as_int(x), 0x121, 0xF, 0xF, true)); }
__device__ __forceinline__ float dpp_next16(float x) { return __int_as_float(__builtin_amdgcn_update_dpp(0, __float_as_int(x), 0x12F, 0xF, 0xF, true)); }
#define MFMA16(a, b, c) __builtin_amdgcn_mfma_f32_16x16x32_bf16((a), (b), (c), 0, 0, 0)
#define MFMA32(a, b, c) __builtin_amdgcn_mfma_f32_32x32x16_bf16((a), (b), (c), 0, 0, 0)

__device__ __forceinline__ void wt_convert(const int tid, ldsp L, const float* __restrict__ w, bf16_t* __restrict__ bt, int K, int N, int Npad, int pairperm, int tstart, int tstride) {
    LAS float* tile = (LAS float*)L;
    const int nkt = K / 64, nnt = Npad / 64, ntile = nkt * nnt;
    for (int t = tstart; t < ntile; t += tstride) {
        const int kt = t % nkt, nt_ = t / nkt, k0 = kt * 64, n0 = nt_ * 64, s0n = pairperm ? (((n0 >> 7) & 1) * 2816 + (n0 >> 8) * 128 + (n0 & 127)) : n0;
#pragma unroll
        for (int i = 0; i < 8; ++i) { const int idx = tid + NTHR * i, kk = idx >> 6, nn = idx & 63; tile[kk * 65 + nn] = (s0n + nn < N) ? w[(size_t)(k0 + kk) * N + s0n + nn] : 0.f; }
        __syncthreads();
#pragma unroll
        for (int i = 0; i < 8; ++i) { const int idx = tid + NTHR * i, nn = idx >> 6, kk = idx & 63; bt[(size_t)(n0 + nn) * K + k0 + kk] = f2bf(tile[kk * 65 + nn]); }
        __syncthreads();
    }
}

template <bool FINAL>
__device__ __forceinline__ void rmsnorm_phase(const int tid, const float* x0, const float* x1, int split, const float* __restrict__ w, bf16_t* dst, float* fdst, const float pe = 0.f, const bf16_t* xb = nullptr) {
    const int lane = tid & 63, wid = tid >> 6;
    f32x4 wv[4];
#pragma unroll
    for (int j = 0; j < 4; ++j) wv[j] = *(const f32x4*)(w + lane * 4 + 256 * j);
    for (int row = blockIdx.x * 8 + wid; row < MTOK; row += gridDim.x * 8) {
        const float* xr = row < split ? x0 + (size_t)row * DMODEL : x1 + (size_t)(row - split) * DMODEL;
        f32x4 v[4]; float ss = 0.f;
#pragma unroll
        for (int j = 0; j < 4; ++j) { if (xb) { const u32x2 t = *(const u32x2*)(xb + (size_t)row * DMODEL + lane * 4 + 256 * j); v[j] = (f32x4){bf_lo(t.x), bf_hi(t.x), bf_lo(t.y), bf_hi(t.y)}; } else v[j] = *(const f32x4*)(xr + lane * 4 + 256 * j); ss += v[j][0] * v[j][0] + v[j][1] * v[j][1] + v[j][2] * v[j][2] + v[j][3] * v[j][3]; }
#pragma unroll
        for (int o = 32; o >= 1; o >>= 1) ss += __shfl_xor(ss, o);
        const float r = rsqrtf(ss * (1.f / 1024.f) + 1e-6f);
#pragma unroll
        for (int j = 0; j < 4; ++j) {
            const f32x4 y = v[j] * r * wv[j];
            if (FINAL) { f32x4 yy = y; yy[0] -= pe; yy[1] += pe; yy[2] -= pe; yy[3] += pe; *(f32x4*)(fdst + (size_t)row * DMODEL + lane * 4 + 256 * j) = yy; }
            else { u32x2 o2; o2.x = cvt_pk_bf16(y[0], y[1]); o2.y = cvt_pk_bf16(y[2], y[3]); *(u32x2*)(dst + (size_t)row * DMODEL + lane * 4 + 256 * j) = o2; }
        }
    }
}

__device__ __forceinline__ void rmsnorm_final_bf16_phase(const int tid, const bf16_t* __restrict__ xb, const float* __restrict__ w, float* __restrict__ out, const float pe) {
    const int lane = tid & 63, wid = tid >> 6, G8 = gridDim.x * 8;
    f32x4 wv[4];
#pragma unroll
    for (int j = 0; j < 2; ++j) { wv[2 * j] = *(const f32x4*)(w + 512 * j + lane * 8); wv[2 * j + 1] = *(const f32x4*)(w + 512 * j + lane * 8 + 4); }
    for (int rowb = blockIdx.x * 8 + wid; rowb < MTOK; rowb += 4 * G8) {
        u32x4 t[4][2];
#pragma unroll
        for (int u = 0; u < 4; ++u) { const int row = rowb + u * G8 < MTOK ? rowb + u * G8 : rowb;
#pragma unroll
            for (int j = 0; j < 2; ++j) t[u][j] = *(const u32x4*)(xb + (size_t)row * DMODEL + 512 * j + lane * 8); }
#pragma unroll
        for (int u = 0; u < 4; ++u) { const int row = rowb + u * G8;
            f32x4 v[4]; float ss = 0.f;
#pragma unroll
            for (int j = 0; j < 2; ++j) { v[2 * j] = (f32x4){bf_lo(t[u][j].x), bf_hi(t[u][j].x), bf_lo(t[u][j].y), bf_hi(t[u][j].y)}; v[2 * j + 1] = (f32x4){bf_lo(t[u][j].z), bf_hi(t[u][j].z), bf_lo(t[u][j].w), bf_hi(t[u][j].w)}; }
#pragma unroll
            for (int j = 0; j < 4; ++j) ss += v[j][0] * v[j][0] + v[j][1] * v[j][1] + v[j][2] * v[j][2] + v[j][3] * v[j][3];
#pragma unroll
            for (int o = 32; o >= 1; o >>= 1) ss += __shfl_xor(ss, o);
            const float r = rsqrtf(ss * (1.f / 1024.f) + 1e-6f);
            if (row < MTOK) {
#pragma unroll
                for (int j = 0; j < 4; ++j) { f32x4 y = v[j] * r * wv[j]; y[0] -= pe; y[1] += pe; y[2] -= pe; y[3] += pe; *(f32x4*)(out + (size_t)row * DMODEL + 512 * (j >> 1) + lane * 8 + 4 * (j & 1)) = y; }
            } }
    }
}

__device__ __forceinline__ void rmsnorm_f32in_phase(const int tid, const float* __restrict__ x0, const float* __restrict__ x1, int split, const float* __restrict__ w, bf16_t* __restrict__ dst) {
    const int lane = tid & 63, wid = tid >> 6, G8 = gridDim.x * 8;
    f32x4 wv[4];
#pragma unroll
    for (int j = 0; j < 2; ++j) { wv[2 * j] = *(const f32x4*)(w + 512 * j + lane * 8); wv[2 * j + 1] = *(const f32x4*)(w + 512 * j + lane * 8 + 4); }
    for (int rowb = blockIdx.x * 8 + wid; rowb < MTOK; rowb += 2 * G8) {
        f32x4 v[2][4];
#pragma unroll
        for (int u = 0; u < 2; ++u) { const int row = rowb + u * G8 < MTOK ? rowb + u * G8 : rowb; const float* xr = row < split ? x0 + (size_t)row * DMODEL : x1 + (size_t)(row - split) * DMODEL;
#pragma unroll
            for (int j = 0; j < 2; ++j) { v[u][2 * j] = *(const f32x4*)(xr + 512 * j + lane * 8); v[u][2 * j + 1] = *(const f32x4*)(xr + 512 * j + lane * 8 + 4); } }
#pragma unroll
        for (int u = 0; u < 2; ++u) { const int row = rowb + u * G8;
            float ss = 0.f;
#pragma unroll
            for (int j = 0; j < 4; ++j) ss += v[u][j][0] * v[u][j][0] + v[u][j][1] * v[u][j][1] + v[u][j][2] * v[u][j][2] + v[u][j][3] * v[u][j][3];
#pragma unroll
            for (int o = 32; o >= 1; o >>= 1) ss += __shfl_xor(ss, o);
            const float r = rsqrtf(ss * (1.f / 1024.f) + 1e-6f);
            if (row < MTOK) {
#pragma unroll
                for (int j = 0; j < 2; ++j) { const f32x4 y0 = v[u][2 * j] * r * wv[2 * j], y1 = v[u][2 * j + 1] * r * wv[2 * j + 1]; u32x4 o; o.x = cvt_pk_bf16(y0[0], y0[1]); o.y = cvt_pk_bf16(y0[2], y0[3]); o.z = cvt_pk_bf16(y1[0], y1[1]); o.w = cvt_pk_bf16(y1[2], y1[3]);
                    *(u32x4*)(dst + (size_t)row * DMODEL + 512 * j + lane * 8) = o; }
            } }
    }
}

__device__ __forceinline__ void rmsnorm_bf16_phase(const int tid, const bf16_t* __restrict__ xb, const float* __restrict__ w, bf16_t* __restrict__ dst) {
    const int lane = tid & 63, wid = tid >> 6, G8 = gridDim.x * 8;
    f32x4 wv[4];
#pragma unroll
    for (int j = 0; j < 2; ++j) { wv[2 * j] = *(const f32x4*)(w + 512 * j + lane * 8); wv[2 * j + 1] = *(const f32x4*)(w + 512 * j + lane * 8 + 4); }
    for (int rowb = blockIdx.x * 8 + wid; rowb < MTOK; rowb += 4 * G8) {
        u32x4 t[4][2];
#pragma unroll
        for (int u = 0; u < 4; ++u) { const int row = rowb + u * G8 < MTOK ? rowb + u * G8 : rowb;
#pragma unroll
            for (int j = 0; j < 2; ++j) t[u][j] = *(const u32x4*)(xb + (size_t)row * DMODEL + 512 * j + lane * 8); }
#pragma unroll
        for (int u = 0; u < 4; ++u) { const int row = rowb + u * G8;
            f32x4 v[4]; float ss = 0.f;
#pragma unroll
            for (int j = 0; j < 2; ++j) { v[2 * j] = (f32x4){bf_lo(t[u][j].x), bf_hi(t[u][j].x), bf_lo(t[u][j].y), bf_hi(t[u][j].y)}; v[2 * j + 1] = (f32x4){bf_lo(t[u][j].z), bf_hi(t[u][j].z), bf_lo(t[u][j].w), bf_hi(t[u][j].w)}; }
#pragma unroll
            for (int j = 0; j < 4; ++j) ss += v[j][0] * v[j][0] + v[j][1] * v[j][1] + v[j][2] * v[j][2] + v[j][3] * v[j][3];
#pragma unroll
            for (int o = 32; o >= 1; o >>= 1) ss += __shfl_xor(ss, o);
            const float r = rsqrtf(ss * (1.f / 1024.f) + 1e-6f);
            if (row < MTOK) {
#pragma unroll
                for (int j = 0; j < 2; ++j) { const f32x4 y0 = v[2 * j] * r * wv[2 * j], y1 = v[2 * j + 1] * r * wv[2 * j + 1]; u32x4 o; o.x = cvt_pk_bf16(y0[0], y0[1]); o.y = cvt_pk_bf16(y0[2], y0[3]); o.z = cvt_pk_bf16(y1[0], y1[1]); o.w = cvt_pk_bf16(y1[2], y1[3]);
                    *(u32x4*)(dst + (size_t)row * DMODEL + 512 * j + lane * 8) = o; }
            } }
    }
}

struct EpiResid {
    static constexpr bool PERM = true, AFTER_DRAIN = false;
    float* outf; bf16_t* ob; const float* r0; const float* r1; int split; const bf16_t* rb;
    __device__ __forceinline__ void load_resid(f32x4 (&rv)[2][2], int row, int col0) const {
        if (rb) { const bf16_t* rp = rb + (size_t)row * DMODEL + col0;
#pragma unroll
            for (int bj = 0; bj < 2; ++bj) { const u32x4 t = *(const u32x4*)(rp + bj * 128); rv[bj][0] = (f32x4){bf_lo(t.x), bf_hi(t.x), bf_lo(t.y), bf_hi(t.y)}; rv[bj][1] = (f32x4){bf_lo(t.z), bf_hi(t.z), bf_lo(t.w), bf_hi(t.w)}; } }
        else { const float* rp = (row < split ? r0 + (size_t)row * DMODEL : r1 + (size_t)(row - split) * DMODEL) + col0;
#pragma unroll
            for (int bj = 0; bj < 2; ++bj)
#pragma unroll
                for (int n = 0; n < 2; ++n) rv[bj][n] = *(const f32x4*)(rp + bj * 128 + n * 4); }
    }
    __device__ __forceinline__ void operator()(const f32x4 (&acc)[2][2][4][2], const Unit& u, int wr, int wc, int fr, int fq) const {
        const int row0 = u.pm * 256 + wr * 64 + fr, col0 = u.pn * 256 + wc * 32 + 8 * fq;
        f32x4 rv[2][2], rn[2][2];
        load_resid(rn, row0, col0);
#pragma unroll
        for (int g = 0; g < 8; ++g) { const int ai = g >> 2, m = g & 3, row = row0 + ai * 128 + m * 16;
#pragma unroll
            for (int bj = 0; bj < 2; ++bj)
#pragma unroll
                for (int n = 0; n < 2; ++n) rv[bj][n] = rn[bj][n];
            if (g < 7) load_resid(rn, row0 + ((g + 1) >> 2) * 128 + ((g + 1) & 3) * 16, col0);
            if (ob) { bf16_t* op = ob + (size_t)row * DMODEL + col0;
#pragma unroll
                for (int bj = 0; bj < 2; ++bj) { const f32x4 y0 = rv[bj][0] + acc[ai][bj][m][0], y1 = rv[bj][1] + acc[ai][bj][m][1]; u32x4 t; t.x = cvt_pk_bf16(y0[0], y0[1]); t.y = cvt_pk_bf16(y0[2], y0[3]); t.z = cvt_pk_bf16(y1[0], y1[1]); t.w = cvt_pk_bf16(y1[2], y1[3]);
                    *(u32x4*)(op + bj * 128) = t; } }
            else { float* op = outf + (size_t)row * DMODEL + col0;
#pragma unroll
                for (int bj = 0; bj < 2; ++bj)
#pragma unroll
                    for (int n = 0; n < 2; ++n) *(f32x4*)(op + bj * 128 + n * 4) = rv[bj][n] + acc[ai][bj][m][n]; }
            asm volatile("" ::: "memory"); }
    }
};

struct EpiFfnUp {
    static constexpr bool PERM = true, AFTER_DRAIN = false;
    bf16_t* hmid; float* raw; const float* cw; const float* cb; ldsp X;
    __device__ __forceinline__ void operator()(const f32x4 (&acc)[2][2][4][2], const Unit& u, int wr, int wc, int fr, int fq) const {
        LAS float* Xf = (LAS float*)X;
        const int cu0 = wc * 32 + 8 * fq;
        f32x4 pw[8];
        { const int c = u.pn * 128 + cu0;
          pw[0] = *(const f32x4*)(cw + c); pw[1] = *(const f32x4*)(cw + 5632 + c); pw[2] = *(const f32x4*)(cw + 2 * 5632 + c); pw[3] = *(const f32x4*)(cb + c);
          pw[4] = *(const f32x4*)(cw + 2816 + c); pw[5] = *(const f32x4*)(cw + 5632 + 2816 + c); pw[6] = *(const f32x4*)(cw + 2 * 5632 + 2816 + c); pw[7] = *(const f32x4*)(cb + 2816 + c); }
#pragma unroll
        for (int ai = 0; ai < 2; ++ai) {
            if (fr == 0) {
#pragma unroll
                for (int bj = 0; bj < 2; ++bj)
#pragma unroll
                    for (int n = 0; n < 2; ++n) *(LAS f32x4*)(Xf + ((2 * ai + wr) * 2 + 0) * 256 + bj * 128 + cu0 + 4 * n) = acc[ai][bj][0][n];
            }
            if (fr == 15) {
#pragma unroll
                for (int bj = 0; bj < 2; ++bj)
#pragma unroll
                    for (int n = 0; n < 2; ++n) *(LAS f32x4*)(Xf + ((2 * ai + wr) * 2 + 1) * 256 + bj * 128 + cu0 + 4 * n) = acc[ai][bj][3][n];
            }
        }
        if (wr == 0 && fr < 2) {
#pragma unroll
            for (int bj = 0; bj < 2; ++bj)
#pragma unroll
                for (int n = 0; n < 2; ++n) *(f32x4*)(raw + ((size_t)u.pm * 4 + fr) * 5632 + bj * 2816 + u.pn * 128 + cu0 + 4 * n) = acc[0][bj][0][n];
        }
        if (wr == 1 && fr >= 14) {
#pragma unroll
            for (int bj = 0; bj < 2; ++bj)
#pragma unroll
                for (int n = 0; n < 2; ++n) *(f32x4*)(raw + ((size_t)u.pm * 4 + 2 + (fr - 14)) * 5632 + bj * 2816 + u.pn * 128 + cu0 + 4 * n) = acc[1][bj][3][n];
        }
        asm volatile("s_waitcnt lgkmcnt(0)" ::: "memory");
        __builtin_amdgcn_s_barrier();
        asm volatile("" ::: "memory");
        __builtin_amdgcn_s_barrier();
        asm volatile("" ::: "memory");
        u32x2 held[2][4];
#pragma unroll
        for (int n = 0; n < 2; ++n) {
            const int c = u.pn * 128 + cu0 + 4 * n;
            const f32x4 wv0 = n == 0 ? pw[0] : *(const f32x4*)(cw + c), wv1 = n == 0 ? pw[1] : *(const f32x4*)(cw + 5632 + c), wv2 = n == 0 ? pw[2] : *(const f32x4*)(cw + 2 * 5632 + c), bv = n == 0 ? pw[3] : *(const f32x4*)(cb + c);
            const f32x4 wg0 = n == 0 ? pw[4] : *(const f32x4*)(cw + 2816 + c), wg1 = n == 0 ? pw[5] : *(const f32x4*)(cw + 5632 + 2816 + c), wg2 = n == 0 ? pw[6] : *(const f32x4*)(cw + 2 * 5632 + 2816 + c), bg = n == 0 ? pw[7] : *(const f32x4*)(cb + 2816 + c);
#pragma unroll
            for (int ai = 0; ai < 2; ++ai) {
                const int blk = 2 * ai + wr;
                f32x4 xp[2], xn[2];
#pragma unroll
                for (int bj = 0; bj < 2; ++bj) {
                    xp[bj] = blk > 0 ? *(LAS const f32x4*)(Xf + ((blk - 1) * 2 + 1) * 256 + bj * 128 + cu0 + 4 * n) : (f32x4){0.f, 0.f, 0.f, 0.f};
                    xn[bj] = blk < 3 ? *(LAS const f32x4*)(Xf + ((blk + 1) * 2 + 0) * 256 + bj * 128 + cu0 + 4 * n) : (f32x4){0.f, 0.f, 0.f, 0.f};
                }
                f32x4 rpm1[2], rn0[2];
#pragma unroll
                for (int bj = 0; bj < 2; ++bj) {
#pragma unroll
                    for (int e = 0; e < 4; ++e) { rpm1[bj][e] = 0.f; rn0[bj][e] = dpp_next16(acc[ai][bj][0][n][e]); }
                }
#pragma unroll
                for (int m = 0; m < 4; ++m) {
                    f32x4 y[2];
#pragma unroll
                    for (int bj = 0; bj < 2; ++bj) {
                        const f32x4 cur = acc[ai][bj][m][n];
                        f32x4 rp, rn1;
#pragma unroll
                        for (int e = 0; e < 4; ++e) { rp[e] = dpp_prev16(cur[e]); rn1[e] = (m < 3) ? dpp_next16(acc[ai][bj][m < 3 ? m + 1 : 3][n][e]) : 0.f; }
                        const f32x4 pedge = (m > 0) ? rpm1[bj] : xp[bj], nedge = (m < 3) ? rn1 : xn[bj];
                        f32x4 prev, next;
#pragma unroll
                        for (int e = 0; e < 4; ++e) { prev[e] = (fr == 0) ? pedge[e] : rp[e]; next[e] = (fr == 15) ? nedge[e] : rn0[bj][e]; }
                        const f32x4 w0 = bj ? wg0 : wv0, w1 = bj ? wg1 : wv1, w2 = bj ? wg2 : wv2, b = bj ? bg : bv;
                        y[bj] = b + w0 * prev + w1 * cur + w2 * next;
                        rpm1[bj] = rp; rn0[bj] = rn1;
                    }
                    u32x2 o; o.x = cvt_pk_bf16(silu_f(y[1][0]) * y[0][0], silu_f(y[1][1]) * y[0][1]); o.y = cvt_pk_bf16(silu_f(y[1][2]) * y[0][2], silu_f(y[1][3]) * y[0][3]);
                    if (n == 0) held[ai][m] = o;
                    else { u32x4 o4; o4.x = held[ai][m].x; o4.y = held[ai][m].y; o4.z = o.x; o4.w = o.y; *(u32x4*)(hmid + (size_t)(u.pm * 256 + ai * 128 + wr * 64 + m * 16 + fr) * 2816 + c - 4) = o4; }
                }
            }
            asm volatile("" ::: "memory");
        }
    }
};
__device__ __forceinline__ void ffn_fix_phase(const int tid, const float* __restrict__ raw, bf16_t* __restrict__ hmid, const float* __restrict__ cw, const float* __restrict__ cb) {
    constexpr int NT = MTOK / 256, NITEM = NT * 2 * 352;
    for (int it = blockIdx.x * NTHR + tid; it < NITEM; it += gridDim.x * NTHR) {
        const int cgp = it % 352, te = it / 352, t = te >> 1, e = te & 1, c = cgp * 8, row = t * 256 + (e ? 255 : 0);
        int s0, s1; seq_bounds(row, s0, s1);
        const float* rc = raw + ((size_t)t * 4 + (e ? 3 : 0)) * 5632;
        const float* rpv = e ? raw + ((size_t)t * 4 + 2) * 5632 : (row > s0 ? raw + ((size_t)(t - 1) * 4 + 3) * 5632 : (const float*)nullptr);
        const float* rnx = e ? (row + 1 < s1 ? raw + ((size_t)(t + 1) * 4 + 0) * 5632 : (const float*)nullptr) : raw + ((size_t)t * 4 + 1) * 5632;
        float y[2][8];
#pragma unroll
        for (int g = 0; g < 2; ++g)
#pragma unroll
            for (int h = 0; h < 2; ++h) {
                const int cc = g * 2816 + c + 4 * h; const f32x4 zero = (f32x4){0.f, 0.f, 0.f, 0.f};
                const f32x4 xc = *(const f32x4*)(rc + cc), xp = rpv ? *(const f32x4*)(rpv + cc) : zero, xn = rnx ? *(const f32x4*)(rnx + cc) : zero;
                const f32x4 v = *(const f32x4*)(cb + cc) + *(const f32x4*)(cw + cc) * xp + *(const f32x4*)(cw + 5632 + cc) * xc + *(const f32x4*)(cw + 2 * 5632 + cc) * xn;
                y[g][4 * h] = v[0]; y[g][4 * h + 1] = v[1]; y[g][4 * h + 2] = v[2]; y[g][4 * h + 3] = v[3];
            }
        u32x4 o; o.x = cvt_pk_bf16(silu_f(y[1][0]) * y[0][0], silu_f(y[1][1]) * y[0][1]); o.y = cvt_pk_bf16(silu_f(y[1][2]) * y[0][2], silu_f(y[1][3]) * y[0][3]);
        o.z = cvt_pk_bf16(silu_f(y[1][4]) * y[0][4], silu_f(y[1][5]) * y[0][5]); o.w = cvt_pk_bf16(silu_f(y[1][6]) * y[0][6], silu_f(y[1][7]) * y[0][7]);
        *(u32x4*)(hmid + (size_t)row * 2816 + c) = o;
    }
}
template <class Epi>
__device__ __forceinline__ void run_gemm(const int tid, ldsp L, const bf16_t* A, const bf16_t* Bt, int M, int N, int K, const Epi& E) {
    pg8::Gemm g; g.A = A; g.Bt = Bt; g.M = M; g.N = N; g.K = K;
    pg8::StaticOrder S; S.init(M, N, (int)gridDim.x, (int)blockIdx.x);
#ifndef NO_GEMM
    pg8::gemm_phase<Epi, pg8::StaticOrder>(L, g, S, E, tid);
#endif
}

constexpr int P_QH = 0  , P_KH = 17408  , P_KT = 34816  , P_VT = 53248, P_LM0 = 71680  , P_LM1 = 89088, P_AT0 = 106496, P_AT1 = 115712, P_SC = 124928;
static_assert(P_SC + 2560 <= LDS_BYTES, "gdn local lds");
constexpr int S_QH = 0, S_KT = 17408, S_TW = 35840, S_AT = 45056, S_SC = 54272, S_BS = 55808  , S_WT = 2 * S_BS;
static_assert(S_WT + 17408 <= LDS_BYTES, "scan lds");
constexpr int GSC_STRIDE = 144;

__device__ __forceinline__ void gdn_local_phase(const int tid0, ldsp L, const Params& p, bf16_t* qkv, const bf16_t* __restrict__ halo, const float* __restrict__ gates,
                                                bf16_t* u_f, bf16_t* u_b, bf16_t* atb, float* gsc) {
    const float* convw = p.in[6];
    float pga = 0.f, pgb = 0.f;
    u32x4 xr[12];
#define P3_LOAD(itv) do { \
        int tidl; asm volatile("v_mov_b32 %0, %1" : "=v"(tidl) : "v"(tid0)); \
        if (tidl < 384) { \
            const int chunkl = (itv) >> 3, headl = (itv) & 7, t0l = chunkl * 64; int s0l, s1l; seq_bounds(t0l, s0l, s1l); \
            const int cgp = tidl % 48, rr = tidl / 48, tensor = cgp >> 4, c8 = (cgp & 15) * 8, col = tensor * 1024 + headl * 128 + c8; \
            _Pragma("unroll") for (int i = 0; i < 12; ++i) { const int lr = 8 * rr - 2 + i; const u32x4 zero = (u32x4){0u, 0u, 0u, 0u}; \
                if (lr < 0) xr[i] = (t0l > s0l) ? *(const u32x4*)(halo + ((size_t)chunkl * 4 + (lr + 2)) * 3072 + col) : zero; \
                else if (lr >= 64) xr[i] = (t0l + 64 < s1l) ? *(const u32x4*)(halo + ((size_t)(chunkl + 1) * 4 + (lr - 62)) * 3072 + col) : zero; \
                else xr[i] = *(const u32x4*)(qkv + (size_t)(t0l + lr) * 3072 + col); } } \
        else { const int dirl = (tidl >> 6) - 6, tl = ((itv) >> 3) * 64 + (tidl & 63), headl = (itv) & 7; \
            pga = gates[(size_t)tl * 32 + dirl * 8 + headl]; pgb = gates[(size_t)tl * 32 + (2 + dirl) * 8 + headl]; } } while (0)
    if ((int)blockIdx.x < (MTOK / 64) * 8) P3_LOAD((int)blockIdx.x);
    int cw_head = -1;
    for (int it = blockIdx.x; it < (MTOK / 64) * 8; it += gridDim.x) {
        int tid; asm volatile("v_mov_b32 %0, %1" : "=v"(tid) : "v"(tid0));
        const int wid = __builtin_amdgcn_readfirstlane(tid >> 6), lane = tid & 63, l15 = lane & 15, q4 = lane >> 4;
        const int chunk = it >> 3, head = it & 7, t0 = chunk * 64, slot = it;
        LAS float* CW = (LAS float*)(L + LDS_XCHG);
        if (head != cw_head) {
            for (int e = tid; e < 5 * 384; e += NTHR) { const int i = e / 384, cc = e % 384, tensor = cc >> 7, c = cc & 127; CW[e] = convw[i * 3072 + tensor * 1024 + head * 128 + c]; }
            cw_head = head;
            __syncthreads();
        }
        if (tid < 384) {
            const int cgp = tid % 48, rr = tid / 48, tensor = cgp >> 4, c8 = (cgp & 15) * 8;
#pragma unroll
            for (int hf = 0; hf < 2; ++hf) {
                float o[4][8];
#pragma unroll
                for (int r = 0; r < 4; ++r)
#pragma unroll
                    for (int c = 0; c < 8; ++c) o[r][c] = 0.f;
#pragma unroll
                for (int i = 0; i < 5; ++i) {
                    const f32x4 wa = *(LAS const f32x4*)(CW + i * 384 + tensor * 128 + c8), wb = *(LAS const f32x4*)(CW + i * 384 + tensor * 128 + c8 + 4);
#pragma unroll
                    for (int r = 0; r < 4; ++r) { const u32x4 x = xr[4 * hf + r + i];
                        o[r][0] += wa[0] * bf_lo(x.x); o[r][1] += wa[1] * bf_hi(x.x); o[r][2] += wa[2] * bf_lo(x.y); o[r][3] += wa[3] * bf_hi(x.y);
                        o[r][4] += wb[0] * bf_lo(x.z); o[r][5] += wb[1] * bf_hi(x.z); o[r][6] += wb[2] * bf_lo(x.w); o[r][7] += wb[3] * bf_hi(x.w); }
                }
#pragma unroll
                for (int r = 0; r < 4; ++r) {
                    float ss = 0.f;
#pragma unroll
                    for (int c = 0; c < 8; ++c) { o[r][c] = silu_f(o[r][c]); ss += o[r][c] * o[r][c]; }
                    ss += __shfl_xor(ss, 1); ss += __shfl_xor(ss, 2); ss += __shfl_xor(ss, 4); ss += __shfl_xor(ss, 8);
                    const float sc = tensor == 2 ? 1.f : rsqrtf(ss + 1e-6f) * (tensor == 0 ? 0.08838834764831845f : 1.f);
#pragma unroll
                    for (int c = 0; c < 8; ++c) o[r][c] *= sc;
                }
                if (tensor < 2) {
                    ldsp base = L + (tensor == 0 ? P_QH : P_KH) + (8 * rr + 4 * hf) * 272 + c8 * 2;
#pragma unroll
                    for (int r = 0; r < 4; ++r) { u32x4 v; v.x = cvt_pk_bf16(o[r][0], o[r][1]); v.y = cvt_pk_bf16(o[r][2], o[r][3]); v.z = cvt_pk_bf16(o[r][4], o[r][5]); v.w = cvt_pk_bf16(o[r][6], o[r][7]); *(LAS u32x4*)(base + r * 272) = v; }
                }
                if (tensor >= 1) {
                    ldsp base = L + (tensor == 1 ? P_KT : P_VT) + c8 * 144 + rr * 16 + hf * 8;
#pragma unroll
                    for (int c = 0; c < 8; ++c) { u32x2 v; v.x = cvt_pk_bf16(o[0][c], o[1][c]); v.y = cvt_pk_bf16(o[2][c], o[3][c]); *(LAS u32x2*)(base + c * 144) = v; }
                }
                FENCE();
            }
        } else {
            const int dir = wid - 6, t = t0 + lane;
            LAS float* SCgc = (LAS float*)(L + P_SC) + dir * 320;
            const float Aexp = expf(p.in[7][dir * 8 + head]), dtb = p.in[8][dir * 8 + head];
            const float a = pga, bb = pgb;
            const float x = a + dtb, sp = fmaxf(x, 0.f) + log1pf(expf(-fabsf(x))), g = -Aexp * sp, beta = 1.f / (1.f + expf(-bb));
            float pre = g;
#pragma unroll
            for (int o = 1; o < 64; o <<= 1) { const float y = __shfl_up(pre, o); if (lane >= o) pre += y; }
            const float tot = __shfl(pre, 63), gc = dir ? (tot - pre + g) : pre;
            const float egc = expf(gc), dec = expf(tot - gc), egl = expf(tot);
            SCgc[lane] = gc; SCgc[64 + lane] = beta; SCgc[128 + lane] = egc;
            float* gs = gsc + ((size_t)slot * 2 + dir) * GSC_STRIDE; gs[lane] = egc; gs[64 + lane] = dec; if (lane == 0) gs[128] = egl;
        }
        __syncthreads();
        if (it + (int)gridDim.x < (MTOK / 64) * 8) P3_LOAD(it + (int)gridDim.x);
#pragma unroll
        for (int j = 0; j < 2; ++j) { const int pi = tid + NTHR * j, row = pi >> 4, ch = pi & 15, dk = 2 * row + (ch >> 3);
            *(u32x4*)(qkv + (size_t)(t0 + row) * 3072 + head * 128 + ch * 8) = *(LAS const u32x4*)(L + P_QH + row * 272 + ch * 16);
            *(u32x4*)(qkv + (size_t)(t0 + row) * 3072 + 1024 + head * 128 + ch * 8) = *(LAS const u32x4*)(L + P_KT + dk * 144 + (ch & 7) * 16); }
        {
            const int mat = wid >> 2, rt = wid & 3;
            ldsp ab = L + (mat ? P_QH : P_KH) + (16 * rt + l15) * 272 + q4 * 16;
            bf16x8 af[4];
#pragma unroll
            for (int kk = 0; kk < 4; ++kk) af[kk] = *(LAS const bf16x8*)(ab + kk * 64);
            LAS const float* SC0 = (LAS const float*)(L + P_SC); LAS const float* SC1 = SC0 + 320;
#pragma unroll
            for (int ct = 0; ct < 4; ++ct) {
                ldsp bb = L + P_KH + (16 * ct + l15) * 272 + q4 * 16;
                f32x4 acc = (f32x4){0.f, 0.f, 0.f, 0.f};
#pragma unroll
                for (int kk = 0; kk < 4; ++kk) acc = MFMA16(af[kk], *(LAS const bf16x8*)(bb + kk * 64), acc);
                const int s = 16 * ct + l15; const float gs0 = SC0[s], gs1 = SC1[s];
#pragma unroll
                for (int j = 0; j < 4; ++j) {
                    const int c = 16 * rt + 4 * q4 + j; const float e0 = __expf(SC0[c] - gs0), e1 = __expf(SC1[c] - gs1);
                    if (mat == 0) {
                        ((LAS float*)(L + P_LM0))[c * 68 + s] = (s < c) ? acc[j] * SC0[64 + c] * e0 : 0.f;
                        ((LAS float*)(L + P_LM1))[(63 - c) * 68 + (63 - s)] = (s > c) ? acc[j] * SC1[64 + c] * e1 : 0.f;
                    } else {
                        *(LAS unsigned short*)(L + P_AT0 + c * 144 + s * 2) = f2bf((s <= c) ? acc[j] * e0 : 0.f);
                        *(LAS unsigned short*)(L + P_AT1 + c * 144 + s * 2) = f2bf((s >= c) ? acc[j] * e1 : 0.f);
                    }
                }
            }
        }
        __syncthreads();
        {
            if (tid < 128) {
                const int d = tid >> 6, t6 = tid & 63, b = t6 >> 4, j = t6 & 15;
                LAS const float* LM = (LAS const float*)(L + (d ? P_LM1 : P_LM0)); LAS float* TM = (LAS float*)(L + (d ? P_QH : P_KH)); float x[16];
#pragma unroll
                for (int i = 0; i < 16; ++i) { float a = (i == j) ? 1.f : 0.f;
#pragma unroll
                    for (int s = 0; s < i; ++s) a -= LM[(16 * b + i) * 68 + 16 * b + s] * x[s];
                    x[i] = a; TM[(16 * b + i) * 68 + 16 * b + j] = a; if ((i & 3) == 3) FENCE(); }
            } else {
                for (int e = tid - 128; e < 3072; e += NTHR - 128) { const int d = e >= 1536, e1 = d ? e - 1536 : e, blk = e1 >> 8, w = e1 & 255, i = w >> 4, j = w & 15;
                    const int bi = blk < 3 ? 0 : (blk < 5 ? 1 : 2), bj = blk < 3 ? blk + 1 : (blk < 5 ? blk - 1 : 3);
                    ((LAS float*)(L + (d ? P_QH : P_KH)))[(16 * bi + i) * 68 + 16 * bj + j] = 0.f; }
            }
            __syncthreads();
            if (tid < 256) {
                const int d = tid >> 7, t7 = tid & 127, hb = t7 >> 6, r0 = 32 * hb, i = (t7 & 63) >> 2, j4 = (t7 & 3) * 4; f32x4 y = (f32x4){0.f, 0.f, 0.f, 0.f};
                LAS const float* LM = (LAS const float*)(L + (d ? P_LM1 : P_LM0)); LAS const float* TM = (LAS const float*)(L + (d ? P_QH : P_KH)); LAS float* YS = (LAS float*)(L + P_KT + d * 4608);
#pragma unroll
                for (int k = 0; k < 16; k += 4) { const f32x4 a = *(LAS const f32x4*)(LM + (r0 + 16 + i) * 68 + r0 + k);
#pragma unroll
                    for (int kk = 0; kk < 4; ++kk) y += a[kk] * *(LAS const f32x4*)(TM + (r0 + k + kk) * 68 + r0 + j4); }
                *(LAS f32x4*)(YS + (hb * 16 + i) * 36 + j4) = y;
            }
            __syncthreads();
            if (tid < 256) {
                const int d = tid >> 7, t7 = tid & 127, hb = t7 >> 6, r0 = 32 * hb, i = (t7 & 63) >> 2, j4 = (t7 & 3) * 4; f32x4 y = (f32x4){0.f, 0.f, 0.f, 0.f};
                LAS float* TM = (LAS float*)(L + (d ? P_QH : P_KH)); LAS const float* YS = (LAS const float*)(L + P_KT + d * 4608);
#pragma unroll
                for (int k = 0; k < 16; k += 4) { const f32x4 a = *(LAS const f32x4*)(TM + (r0 + 16 + i) * 68 + r0 + 16 + k);
#pragma unroll
                    for (int kk = 0; kk < 4; ++kk) y -= a[kk] * *(LAS const f32x4*)(YS + (hb * 16 + k + kk) * 36 + j4); }
                *(LAS f32x4*)(TM + (r0 + 16 + i) * 68 + r0 + j4) = y;
            }
            __syncthreads();
            {
                const int d = tid >> 8, t8 = tid & 255, i = t8 >> 3, j4 = (t8 & 7) * 4; f32x4 y = (f32x4){0.f, 0.f, 0.f, 0.f};
                LAS const float* LM = (LAS const float*)(L + (d ? P_LM1 : P_LM0)); LAS const float* TM = (LAS const float*)(L + (d ? P_QH : P_KH)); LAS float* YS = (LAS float*)(L + P_KT + d * 4608);
#pragma unroll
                for (int k = 0; k < 32; k += 4) { const f32x4 a = *(LAS const f32x4*)(LM + (32 + i) * 68 + k);
#pragma unroll
                    for (int kk = 0; kk < 4; ++kk) y += a[kk] * *(LAS const f32x4*)(TM + (k + kk) * 68 + j4); }
                *(LAS f32x4*)(YS + i * 36 + j4) = y;
            }
            __syncthreads();
            {
                const int d = tid >> 8, t8 = tid & 255, i = t8 >> 3, j4 = (t8 & 7) * 4; f32x4 y = (f32x4){0.f, 0.f, 0.f, 0.f};
                LAS float* TM = (LAS float*)(L + (d ? P_QH : P_KH)); LAS const float* YS = (LAS const float*)(L + P_KT + d * 4608);
#pragma unroll
                for (int k = 0; k < 32; k += 4) { const f32x4 a = *(LAS const f32x4*)(TM + (32 + i) * 68 + 32 + k);
#pragma unroll
                    for (int kk = 0; kk < 4; ++kk) y -= a[kk] * *(LAS const f32x4*)(YS + (k + kk) * 36 + j4); }
                *(LAS f32x4*)(TM + (32 + i) * 68 + j4) = y;
            }
            __syncthreads();
#pragma unroll
            for (int dir = 0; dir < 2; ++dir) {
                LAS const float* TM = (LAS const float*)(L + (dir ? P_QH : P_KH)); LAS const float* SCd = (LAS const float*)(L + P_SC) + dir * 320;
                const int c = tid >> 3, s8 = (tid & 7) * 8, fc = dir ? 63 - c : c; float tb[8], tw[8];
#pragma unroll
                for (int e = 0; e < 8; ++e) { const int s = s8 + e, fs = dir ? 63 - s : s; const float tv = TM[fc * 68 + fs]; tb[e] = tv * SCd[64 + s]; tw[e] = tb[e] * SCd[128 + s]; }
                u32x4 v; v.x = cvt_pk_bf16(tb[0], tb[1]); v.y = cvt_pk_bf16(tb[2], tb[3]); v.z = cvt_pk_bf16(tb[4], tb[5]); v.w = cvt_pk_bf16(tb[6], tb[7]);
                u32x4 w2; w2.x = cvt_pk_bf16(tw[0], tw[1]); w2.y = cvt_pk_bf16(tw[2], tw[3]); w2.z = cvt_pk_bf16(tw[4], tw[5]); w2.w = cvt_pk_bf16(tw[6], tw[7]);
                *(u32x4*)(qkv + (size_t)(t0 + 32 * dir + (c >> 1)) * 3072 + 2048 + head * 128 + (c & 1) * 64 + s8) = w2;
                *(u32x4*)(atb + ((size_t)slot * 2 + dir) * 4096 + c * 64 + s8) = *(LAS const u32x4*)(L + (dir ? P_AT1 : P_AT0) + c * 144 + s8 * 2);
                *(LAS u32x4*)(L + P_LM0 + dir * 9216 + c * 144 + s8 * 2) = v;
            }
            __syncthreads();
#pragma unroll
            for (int dir = 0; dir < 2; ++dir) {
                const int dv0 = 16 * wid; f32x4 vn[4];
#pragma unroll
                for (int ct = 0; ct < 4; ++ct) vn[ct] = (f32x4){0.f, 0.f, 0.f, 0.f};
#pragma unroll
                for (int kk = 0; kk < 2; ++kk) { const bf16x8 bv = *(LAS const bf16x8*)(L + P_VT + (dv0 + l15) * 144 + kk * 64 + q4 * 16);
#pragma unroll
                    for (int ct = 0; ct < 4; ++ct) vn[ct] = MFMA16(*(LAS const bf16x8*)(L + P_LM0 + dir * 9216 + (16 * ct + l15) * 144 + kk * 64 + q4 * 16), bv, vn[ct]); }
                bf16_t* ub = (dir ? u_b : u_f) + ((size_t)slot * 128 + dv0 + l15) * 64 + 16 * q4;
#pragma unroll
                for (int h = 0; h < 2; ++h) { u32x4 v; v.x = cvt_pk_bf16(vn[2 * h][0], vn[2 * h][1]); v.y = cvt_pk_bf16(vn[2 * h][2], vn[2 * h][3]); v.z = cvt_pk_bf16(vn[2 * h + 1][0], vn[2 * h + 1][1]); v.w = cvt_pk_bf16(vn[2 * h + 1][2], vn[2 * h + 1][3]); *(u32x4*)(ub + 8 * h) = v; }
            }
            __syncthreads();
        }
    }
}

#undef P3_LOAD
__device__ __forceinline__ void gdn_scan_item(const int tid0, ldsp L, int gi, const int dvbase, const int nact, const bf16_t* __restrict__ qkv, bf16_t* u_f, bf16_t* u_b, const bf16_t* __restrict__ atb, const float* __restrict__ gsc, bf16_t* op_f, bf16_t* op_b) {
    int head, dir, tbase, nsteps;
    if (gi < 16) { head = gi & 7; dir = gi >> 3; tbase = 0; nsteps = TPROMPT / 64; }
    else { const int j = gi - 16; head = j & 7; dir = (j >> 3) & 1; tbase = TPROMPT + (j >> 4) * TSAMP; nsteps = TSAMP / 64; }
    bf16_t* ubuf = dir ? u_b : u_f; bf16_t* opbuf = dir ? op_b : op_f;
    f32x4 S[8];
#pragma unroll
    for (int i = 0; i < 8; ++i) S[i] = (f32x4){0.f, 0.f, 0.f, 0.f};
    u32x4 pq[2], pk[2], ptw, pat; u32x2 pu[4]; float psc = 0.f;
#pragma unroll
    for (int ct = 0; ct < 4; ++ct) pu[ct] = (u32x2){0u, 0u};
#define GDN_PREFETCH(stepv) do { \
        int tidp; asm volatile("v_mov_b32 %0, %1" : "=v"(tidp) : "v"(tid0)); \
        const int chunkp = dir ? nsteps - 1 - (stepv) : (stepv), t0p = tbase + 64 * chunkp, slotp = (t0p >> 6) * 8 + head, lanep = tidp & 63, widp = __builtin_amdgcn_readfirstlane(tidp >> 6); \
        const bf16_t* up = ubuf + ((size_t)slotp * 128 + dvbase + 16 * widp + (lanep & 15)) * 64 + 16 * (lanep >> 4); \
        if (widp < nact) { const u32x4 p01 = *(const u32x4*)up, p23 = *(const u32x4*)(up + 8); pu[0] = (u32x2){p01.x, p01.y}; pu[1] = (u32x2){p01.z, p01.w}; pu[2] = (u32x2){p23.x, p23.y}; pu[3] = (u32x2){p23.z, p23.w}; } \
        _Pragma("unroll") for (int j = 0; j < 2; ++j) { const int pi = tidp + NTHR * j, row = pi >> 4, ch = pi & 15; \
            pq[j] = *(const u32x4*)(qkv + (size_t)(t0p + row) * 3072 + head * 128 + ch * 8); pk[j] = *(const u32x4*)(qkv + (size_t)(t0p + row) * 3072 + 1024 + head * 128 + ch * 8); } \
        ptw = *(const u32x4*)(qkv + (size_t)(t0p + 32 * dir + (tidp >> 4)) * 3072 + 2048 + head * 128 + (tidp & 15) * 8); \
        pat = *(const u32x4*)(atb + ((size_t)slotp * 2 + dir) * 4096 + tidp * 8); \
        psc = (tidp < 129) ? gsc[((size_t)slotp * 2 + dir) * GSC_STRIDE + tidp] : 0.f; } while (0)
#define GDN_STAGE(bo) do { \
        int tids; asm volatile("v_mov_b32 %0, %1" : "=v"(tids) : "v"(tid0)); \
        _Pragma("unroll") for (int j = 0; j < 2; ++j) { const int pi = tids + NTHR * j, row = pi >> 4, ch = pi & 15, dk = 2 * row + (ch >> 3); \
            *(LAS u32x4*)(L + (bo) + S_QH + row * 272 + ch * 16) = pq[j]; *(LAS u32x4*)(L + (bo) + S_KT + dk * 144 + (ch & 7) * 16) = pk[j]; } \
        { const int c = 2 * (tids >> 4) + ((tids & 15) >> 3); *(LAS u32x4*)(L + (bo) + S_TW + c * 144 + (tids & 7) * 16) = ptw; } \
        *(LAS u32x4*)(L + (bo) + S_AT + (tids >> 3) * 144 + (tids & 7) * 16) = pat; \
        if (tids < 129) ((LAS float*)(L + (bo) + S_SC))[tids] = psc; } while (0)
    u32x2 uc[4], un[4];
    GDN_PREFETCH(0);
    GDN_STAGE(0);
#pragma unroll
    for (int ct = 0; ct < 4; ++ct) { uc[ct] = pu[ct]; un[ct] = pu[ct]; }
    if (nsteps > 1) GDN_PREFETCH(1);
    __syncthreads();
    for (int step = 0; step < nsteps; ++step) {
        int tid; asm volatile("v_mov_b32 %0, %1" : "=v"(tid) : "v"(tid0));
        const int wid = __builtin_amdgcn_readfirstlane(tid >> 6), lane = tid & 63, l15 = lane & 15, q4 = lane >> 4;
        const int chunk = dir ? nsteps - 1 - step : step, t0 = tbase + 64 * chunk, slot = (t0 >> 6) * 8 + head;
        const int bo = (step & 1) * S_BS, bn = S_BS - bo;
        {
            ldsp ab = L + bo + S_KT + (16 * wid + l15) * 144 + q4 * 16;
            const bf16x8 a0 = *(LAS const bf16x8*)ab, a1 = *(LAS const bf16x8*)(ab + 64);
#pragma unroll
            for (int ct = 0; ct < 4; ++ct) {
                ldsp bb = L + bo + S_TW + (16 * ct + l15) * 144 + q4 * 16;
                f32x4 acc = (f32x4){0.f, 0.f, 0.f, 0.f};
                acc = MFMA16(a0, *(LAS const bf16x8*)bb, acc); acc = MFMA16(a1, *(LAS const bf16x8*)(bb + 64), acc);
                u32x2 v; v.x = cvt_pk_bf16(-acc[0], -acc[1]); v.y = cvt_pk_bf16(-acc[2], -acc[3]);
                *(LAS u32x2*)(L + S_WT + (16 * ct + l15) * 272 + (16 * wid + 4 * q4) * 2) = v;
            }
        }
        __syncthreads();
        if (step + 1 < nsteps) {
            GDN_STAGE(bn);
#pragma unroll
            for (int ct = 0; ct < 4; ++ct) un[ct] = pu[ct];
            if (step + 2 < nsteps) GDN_PREFETCH(step + 2);
        }
        if (wid < nact) {
            const int dv0 = dvbase + 16 * wid;
            LAS const float* SCegc = (LAS const float*)(L + bo + S_SC); LAS const float* SCdec = SCegc + 64;
            f32x4 vn[4], R[4];
#pragma unroll
            for (int ct = 0; ct < 4; ++ct) { vn[ct][0] = bf_lo(uc[ct].x); vn[ct][1] = bf_hi(uc[ct].x); vn[ct][2] = bf_lo(uc[ct].y); vn[ct][3] = bf_hi(uc[ct].y); R[ct] = (f32x4){0.f, 0.f, 0.f, 0.f}; }
#pragma unroll
            for (int kk = 0; kk < 4; ++kk) {
                const bf16x8 sb = pack8(S[2 * kk], S[2 * kk + 1]);
#pragma unroll
                for (int ct = 0; ct < 4; ++ct) { const int off = (16 * ct + l15) * 272 + (32 * kk + 4 * q4) * 2;
                    vn[ct] = MFMA16(lds_read2(L + S_WT + off), sb, vn[ct]); R[ct] = MFMA16(lds_read2(L + bo + S_QH + off), sb, R[ct]); }
                FENCE();
            }
#pragma unroll
            for (int ct = 0; ct < 4; ++ct) R[ct] *= *(LAS const f32x4*)(SCegc + 16 * ct + 4 * q4);
            bf16x8 Vb[2], Vd[2];
#pragma unroll
            for (int kk = 0; kk < 2; ++kk) { Vb[kk] = pack8(vn[2 * kk], vn[2 * kk + 1]);
                Vd[kk] = pack8(vn[2 * kk] * *(LAS const f32x4*)(SCdec + 32 * kk + 4 * q4), vn[2 * kk + 1] * *(LAS const f32x4*)(SCdec + 32 * kk + 16 + 4 * q4)); }
            FENCE();
#pragma unroll
            for (int kk = 0; kk < 2; ++kk)
#pragma unroll
                for (int ct = 0; ct < 4; ++ct) R[ct] = MFMA16(lds_read2(L + bo + S_AT + (16 * ct + l15) * 144 + (32 * kk + 4 * q4) * 2), Vb[kk], R[ct]);
            if (opbuf) {
                bf16_t* ob = opbuf + ((size_t)slot * 128 + dv0 + l15) * 64 + 16 * q4;
#pragma unroll
                for (int h = 0; h < 2; ++h) { u32x4 v; v.x = cvt_pk_bf16(R[2 * h][0], R[2 * h][1]); v.y = cvt_pk_bf16(R[2 * h][2], R[2 * h][3]); v.z = cvt_pk_bf16(R[2 * h + 1][0], R[2 * h + 1][1]); v.w = cvt_pk_bf16(R[2 * h + 1][2], R[2 * h + 1][3]); *(u32x4*)(ob + 8 * h) = v; }
            } else {
                bf16_t* ob = ubuf + (size_t)slot * 8192 + dv0 + l15;
#pragma unroll
                for (int ct = 0; ct < 4; ++ct)
#pragma unroll
                    for (int j = 0; j < 4; ++j) ob[(16 * ct + 4 * q4 + j) * 128] = f2bf(R[ct][j]);
            }
            FENCE();
            const float egl = SCegc[128];
#pragma unroll
            for (int dkt = 0; dkt < 8; ++dkt) { S[dkt] *= egl;
#pragma unroll
                for (int kk = 0; kk < 2; ++kk) S[dkt] = MFMA16(lds_read2(L + bo + S_KT + (16 * dkt + l15) * 144 + (32 * kk + 4 * q4) * 2), Vd[kk], S[dkt]);
                if (dkt & 1) FENCE(); }
        }
#pragma unroll
        for (int ct = 0; ct < 4; ++ct) uc[ct] = un[ct];
        __syncthreads();
    }
#undef GDN_STAGE
#undef GDN_PREFETCH
}
constexpr int PSPLIT = 4;
__device__ __forceinline__ void gdn_scan_phase(const int tid, ldsp L, const bf16_t* qkv, bf16_t* u_f, bf16_t* u_b, const bf16_t* atb, const float* gsc, bf16_t* op_f, bf16_t* op_b) {
    const int b = blockIdx.x, G = gridDim.x;
    constexpr int NP = 16 * PSPLIT, NIT = NP + 256;
    for (int k = 0; k < 4; ++k) {
        int it;
        if (k == 0) it = b; else { if (b < NP || G <= NP) break; it = G + (k - 1) * (G - NP) + (b - NP); }
        if (it >= NIT) break;
        int gi, dvbase, nact; const bool prompt = it < NP;
        if (prompt) { gi = it / PSPLIT; dvbase = (it % PSPLIT) * (128 / PSPLIT); nact = 8 / PSPLIT; } else { gi = 16 + (it - NP); dvbase = 0; nact = 8; }
        __syncthreads();
        gdn_scan_item(tid, L, gi, dvbase, nact, qkv, u_f, u_b, atb, gsc, prompt ? op_f : (bf16_t*)nullptr, prompt ? op_b : (bf16_t*)nullptr);
    }
}

__device__ __forceinline__ void gdn_combine_phase(const int tid0, ldsp L, const Params& p, const bf16_t* o_f, const bf16_t* o_b, const bf16_t* z, bf16_t* dst, const bf16_t* __restrict__ op_f, const bf16_t* __restrict__ op_b) {
    const float* nw = p.in[9];
    LAS float* T = (LAS float*)L;
    for (int it = blockIdx.x; it < (TPROMPT / 64) * 8; it += gridDim.x) {
        int tid; asm volatile("v_mov_b32 %0, %1" : "=v"(tid) : "v"(tid0));
        const int chunk = it >> 3, head = it & 7, t0 = chunk * 64;
        __syncthreads();
#pragma unroll
        for (int j = 0; j < 2; ++j) { const int pi = tid + NTHR * j, dv = pi >> 3, c8 = (pi & 7) * 8; const size_t off = ((size_t)it * 128 + dv) * 64 + c8;
            const u32x4 a = *(const u32x4*)(op_f + off), b = *(const u32x4*)(op_b + off);
            const int cA = 16 * ((c8 >> 2) & 3) + 4 * (c8 >> 4), cB = cA + 16;
            T[(cA + 0) * 132 + dv] = bf_lo(a.x) + bf_lo(b.x); T[(cA + 1) * 132 + dv] = bf_hi(a.x) + bf_hi(b.x); T[(cA + 2) * 132 + dv] = bf_lo(a.y) + bf_lo(b.y); T[(cA + 3) * 132 + dv] = bf_hi(a.y) + bf_hi(b.y);
            T[(cB + 0) * 132 + dv] = bf_lo(a.z) + bf_lo(b.z); T[(cB + 1) * 132 + dv] = bf_hi(a.z) + bf_hi(b.z); T[(cB + 2) * 132 + dv] = bf_lo(a.w) + bf_lo(b.w); T[(cB + 3) * 132 + dv] = bf_hi(a.w) + bf_hi(b.w); }
        __syncthreads();
        const int c = tid >> 3, d16 = (tid & 7) * 16;
        float o[16]; float ss = 0.f;
#pragma unroll
        for (int e4 = 0; e4 < 4; ++e4) { const f32x4 v = *(LAS const f32x4*)(T + c * 132 + d16 + 4 * e4); o[4 * e4] = v[0]; o[4 * e4 + 1] = v[1]; o[4 * e4 + 2] = v[2]; o[4 * e4 + 3] = v[3]; ss += v[0] * v[0] + v[1] * v[1] + v[2] * v[2] + v[3] * v[3]; }
        ss += __shfl_xor(ss, 1); ss += __shfl_xor(ss, 2); ss += __shfl_xor(ss, 4);
        const float r = rsqrtf(ss * (1.f / 128.f) + 1e-6f);
        const size_t zoff = (size_t)(t0 + c) * 1024 + head * 128 + d16;
        const u32x4 z0 = *(const u32x4*)(z + zoff), z1 = *(const u32x4*)(z + zoff + 8);
        const unsigned zz[8] = {z0.x, z0.y, z0.z, z0.w, z1.x, z1.y, z1.z, z1.w};
        unsigned ov[8];
#pragma unroll
        for (int e2 = 0; e2 < 8; ++e2) { const float y0 = o[2 * e2] * r * nw[d16 + 2 * e2] * silu_f(bf_lo(zz[e2])), y1 = o[2 * e2 + 1] * r * nw[d16 + 2 * e2 + 1] * silu_f(bf_hi(zz[e2])); ov[e2] = cvt_pk_bf16(y0, y1); }
        u32x4 v0, v1; v0.x = ov[0]; v0.y = ov[1]; v0.z = ov[2]; v0.w = ov[3]; v1.x = ov[4]; v1.y = ov[5]; v1.z = ov[6]; v1.w = ov[7];
        *(u32x4*)(dst + zoff) = v0; *(u32x4*)(dst + zoff + 8) = v1;
    }
    int tid; asm volatile("v_mov_b32 %0, %1" : "=v"(tid) : "v"(tid0));
    const int lane = tid & 63, wid = tid >> 6, d8 = (lane & 15) * 8;
    const f32x4 w0 = *(const f32x4*)(nw + d8), w1 = *(const f32x4*)(nw + d8 + 4);
    const int SW = gridDim.x * 8;
    for (int it0 = TPROMPT * 2 + blockIdx.x * 8 + wid; it0 < MTOK * 2; it0 += 2 * SW) {
        u32x4 zz2[2], a2[2], b2[2];
#pragma unroll
        for (int u = 0; u < 2; ++u) { const int it = it0 + u * SW < MTOK * 2 ? it0 + u * SW : it0; const int tk = it >> 1, hd = (it & 1) * 4 + (lane >> 4);
            const size_t off = (size_t)tk * 1024 + (it & 1) * 512 + lane * 8, ooff = ((size_t)((tk >> 6) * 8 + hd) * 64 + (tk & 63)) * 128 + d8;
            zz2[u] = *(const u32x4*)(z + off); a2[u] = *(const u32x4*)(o_f + ooff); b2[u] = *(const u32x4*)(o_b + ooff); }
#pragma unroll
        for (int u = 0; u < 2; ++u) { const int it = it0 + u * SW; if (it >= MTOK * 2) break;
            const int tk = it >> 1; const size_t off = (size_t)tk * 1024 + (it & 1) * 512 + lane * 8;
            const u32x4 zz = zz2[u], a = a2[u], b = b2[u];
            float o[8];
            o[0] = bf_lo(a.x) + bf_lo(b.x); o[1] = bf_hi(a.x) + bf_hi(b.x); o[2] = bf_lo(a.y) + bf_lo(b.y); o[3] = bf_hi(a.y) + bf_hi(b.y); o[4] = bf_lo(a.z) + bf_lo(b.z); o[5] = bf_hi(a.z) + bf_hi(b.z); o[6] = bf_lo(a.w) + bf_lo(b.w); o[7] = bf_hi(a.w) + bf_hi(b.w);
            const float zf[8] = {bf_lo(zz.x), bf_hi(zz.x), bf_lo(zz.y), bf_hi(zz.y), bf_lo(zz.z), bf_hi(zz.z), bf_lo(zz.w), bf_hi(zz.w)};
            float ss = 0.f;
#pragma unroll
            for (int e = 0; e < 8; ++e) ss += o[e] * o[e];
            ss += __shfl_xor(ss, 1); ss += __shfl_xor(ss, 2); ss += __shfl_xor(ss, 4); ss += __shfl_xor(ss, 8);
            const float r = rsqrtf(ss * (1.f / 128.f) + 1e-6f);
            float y[8];
#pragma unroll
            for (int e = 0; e < 8; ++e) y[e] = o[e] * r * (e < 4 ? w0[e] : w1[e - 4]) * silu_f(zf[e]);
            u32x4 v; v.x = cvt_pk_bf16(y[0], y[1]); v.y = cvt_pk_bf16(y[2], y[3]); v.z = cvt_pk_bf16(y[4], y[5]); v.w = cvt_pk_bf16(y[6], y[7]);
            *(u32x4*)(dst + off) = v; }
    }
}

__device__ __forceinline__ void ffn_act_phase(const int tid, const bf16_t* __restrict__ up, bf16_t* __restrict__ hmid, const float* __restrict__ cw, const float* __restrict__ cb, int slab_row0, int slab_rows) {
    constexpr int RUN = 8, NCG = 352; const int NITEM = NCG * (slab_rows / RUN);
    for (int it = blockIdx.x * NTHR + tid; it < NITEM; it += gridDim.x * NTHR) {
        const int cgp = it % NCG, run = it / NCG, c = cgp * 8, lr0 = run * RUN;
        int s0, s1; seq_bounds(slab_row0 + lr0, s0, s1); s0 -= slab_row0; s1 -= slab_row0;
        const u32x4 zero = (u32x4){0u, 0u, 0u, 0u};
        u32x4 xv[RUN + 2], xg[RUN + 2];
#pragma unroll
        for (int i = 0; i < RUN + 2; ++i) { const int lr = lr0 - 1 + i; const bool ok = (i > 0 || lr >= s0) && (i < RUN + 1 || lr < s1);
            xv[i] = ok ? *(const u32x4*)(up + (size_t)lr * 5632 + c) : zero; xg[i] = ok ? *(const u32x4*)(up + (size_t)lr * 5632 + 2816 + c) : zero; }
        f32x4 wv[3][2], wg[3][2], bv[2], bg[2];
#pragma unroll
        for (int i = 0; i < 3; ++i)
#pragma unroll
            for (int h = 0; h < 2; ++h) { wv[i][h] = *(const f32x4*)(cw + i * 5632 + c + 4 * h); wg[i][h] = *(const f32x4*)(cw + i * 5632 + 2816 + c + 4 * h); }
#pragma unroll
        for (int h = 0; h < 2; ++h) { bv[h] = *(const f32x4*)(cb + c + 4 * h); bg[h] = *(const f32x4*)(cb + 2816 + c + 4 * h); }
#pragma unroll
        for (int r = 0; r < RUN; ++r) {
            float y[8];
#pragma unroll
            for (int e2 = 0; e2 < 4; ++e2) {
                const unsigned a0 = xv[r][e2], a1 = xv[r + 1][e2], a2 = xv[r + 2][e2], g0 = xg[r][e2], g1 = xg[r + 1][e2], g2 = xg[r + 2][e2];
                const int h = e2 >> 1, k = (e2 & 1) * 2;
                const float v0 = bv[h][k] + wv[0][h][k] * bf_lo(a0) + wv[1][h][k] * bf_lo(a1) + wv[2][h][k] * bf_lo(a2), v1 = bv[h][k + 1] + wv[0][h][k + 1] * bf_hi(a0) + wv[1][h][k + 1] * bf_hi(a1) + wv[2][h][k + 1] * bf_hi(a2);
                const float q0 = bg[h][k] + wg[0][h][k] * bf_lo(g0) + wg[1][h][k] * bf_lo(g1) + wg[2][h][k] * bf_lo(g2), q1 = bg[h][k + 1] + wg[0][h][k + 1] * bf_hi(g0) + wg[1][h][k + 1] * bf_hi(g1) + wg[2][h][k + 1] * bf_hi(g2);
                y[2 * e2] = silu_f(q0) * v0; y[2 * e2 + 1] = silu_f(q1) * v1;
            }
            u32x4 v; v.x = cvt_pk_bf16(y[0], y[1]); v.y = cvt_pk_bf16(y[2], y[3]); v.z = cvt_pk_bf16(y[4], y[5]); v.w = cvt_pk_bf16(y[6], y[7]);
            *(u32x4*)(hmid + (size_t)(lr0 + r) * 2816 + c) = v;
        }
    }
}

__device__ __forceinline__ int t5_bucket_abs(int n) { return n < 8 ? n : (n < 15 ? 8 : n < 27 ? 9 : n < 50 ? 10 : n < 91 ? 11 : n < 166 ? 12 : n < 305 ? 13 : n < 559 ? 14 : 15); }
constexpr int A_VT = 0, A_VTP = 392  , A_BIAS = 64 * A_VTP * 2;
__device__ __forceinline__ void attn_phase(const int tid0, ldsp L, const Params& p, const bf16_t* __restrict__ qkv, bf16_t* __restrict__ ao, float* __restrict__ lse) {
    LAS float* BT = (LAS float*)(L + A_BIAS);
    const float* rel_bias = p.in[13];
    for (int it = blockIdx.x; it < (MTOK / 256) * 12; it += gridDim.x) {
        int tid; asm volatile("v_mov_b32 %0, %1" : "=v"(tid) : "v"(tid0));
        const int wid = __builtin_amdgcn_readfirstlane(tid >> 6), lane = tid & 63, n32 = lane & 31, h2 = lane >> 5;
        const int tb = it / 12, head = it % 12, g = head >> 2, dsh = 2 * g, d = 1 << dsh;
        int s0, Ts, lb;
        if (tb < 64) { s0 = 0; Ts = TPROMPT; lb = tb; } else { s0 = TPROMPT + ((tb - 64) >> 4) * TSAMP; Ts = TSAMP; lb = (tb - 64) & 15; }
        const int Lq = Ts >> dsh, r = lb & (d - 1), st = lb >> dsh, p0 = 256 * st;
        __syncthreads();
        if (tid < 129) { const int rel = (tid - 64) * d, n = rel < 0 ? -rel : rel; BT[tid] = rel_bias[((rel > 0 ? 16 : 0) + t5_bucket_abs(n)) * 12 + head]; }
        u32x4 vv[6];
#pragma unroll
        for (int i = 0; i < 6; ++i) {
            const int idx = tid + NTHR * i, key = idx >> 3, ch = idx & 7; int pk = p0 - 64 + key; pk = pk < 0 ? 0 : (pk >= Lq ? Lq - 1 : pk);
            vv[i] = *(const u32x4*)(qkv + (size_t)(s0 + (pk << dsh) + r) * 2304 + 1536 + head * 64 + ch * 8);
        }
        const int qp = p0 + 32 * wid + n32; const size_t qtok = (size_t)(s0 + (qp << dsh) + r);
        bf16x8 qf[4];
#pragma unroll
        for (int kk = 0; kk < 4; ++kk) qf[kk] = *(const bf16x8*)(qkv + qtok * 2304 + head * 64 + 16 * kk + 8 * h2);
        f32x16 sc[5];
#pragma unroll
        for (int jt = 0; jt < 5; ++jt) {
            int kp = p0 + 32 * wid - 64 + 32 * jt + n32; kp = kp < 0 ? 0 : (kp >= Lq ? Lq - 1 : kp);
            const bf16_t* kr = qkv + (size_t)(s0 + (kp << dsh) + r) * 2304 + 768 + head * 64 + 8 * h2;
            f32x16 a;
#pragma unroll
            for (int e = 0; e < 16; ++e) a[e] = 0.f;
#pragma unroll
            for (int kk = 0; kk < 4; ++kk) a = MFMA32(*(const bf16x8*)(kr + 16 * kk), qf[kk], a);
            sc[jt] = a;
        }
#pragma unroll
        for (int i = 0; i < 6; ++i) {
            const int idx = tid + NTHR * i, key = idx >> 3, ch = idx & 7; const u32x4 v = vv[i];
            LAS unsigned short* vt = (LAS unsigned short*)(L + A_VT) + (ch * 8) * A_VTP + key;
            vt[0] = (unsigned short)(v.x & 0xffffu); vt[A_VTP] = (unsigned short)(v.x >> 16); vt[2 * A_VTP] = (unsigned short)(v.y & 0xffffu); vt[3 * A_VTP] = (unsigned short)(v.y >> 16);
            vt[4 * A_VTP] = (unsigned short)(v.z & 0xffffu); vt[5 * A_VTP] = (unsigned short)(v.z >> 16); vt[6 * A_VTP] = (unsigned short)(v.w & 0xffffu); vt[7 * A_VTP] = (unsigned short)(v.w >> 16);
        }
        __syncthreads();
        float mx = -3.0e38f, sum = 0.f;
        const bool interior = (p0 + 32 * wid - 64 >= 0) && (p0 + 32 * wid + 95 < Lq);
        if (interior) {
            const int dl = 4 * h2 - n32;
#pragma unroll
            for (int jt = 0; jt < 5; ++jt)
#pragma unroll
                for (int e = 0; e < 16; ++e) {
                    const int rel = 32 * jt - 64 + (e & 3) + 8 * (e >> 2) + dl;
                    float lg = sc[jt][e] * 0.125f + BT[(jt == 0 ? (rel < -64 ? -64 : rel) : (jt == 4 ? (rel > 64 ? 64 : rel) : rel)) + 64];
                    if (jt == 0) lg = rel >= -64 ? lg : -1.0e30f;
                    if (jt == 4) lg = rel <= 64 ? lg : -1.0e30f;
                    sc[jt][e] = lg; mx = fmaxf(mx, lg);
                }
            mx = fmaxf(mx, __shfl_xor(mx, 32));
#pragma unroll
            for (int jt = 0; jt < 5; ++jt)
#pragma unroll
                for (int e = 0; e < 16; ++e) { float pe = __expf(sc[jt][e] - mx); if (jt == 0 || jt == 4) pe = sc[jt][e] > -1.0e29f ? pe : 0.f; sc[jt][e] = pe; sum += pe; }
        } else {
#pragma unroll
            for (int jt = 0; jt < 5; ++jt)
#pragma unroll
                for (int e = 0; e < 16; ++e) {
                    const int m = (e & 3) + 8 * (e >> 2) + 4 * h2, rel = 32 * jt - 64 + m - n32, kp = qp + rel;
                    const bool ok = rel >= -64 && rel <= 64 && kp >= 0 && kp < Lq;
                    const float lg = ok ? sc[jt][e] * 0.125f + BT[ok ? rel + 64 : 64] : -1.0e30f;
                    sc[jt][e] = lg; mx = fmaxf(mx, lg);
                }
            mx = fmaxf(mx, __shfl_xor(mx, 32));
#pragma unroll
            for (int jt = 0; jt < 5; ++jt)
#pragma unroll
                for (int e = 0; e < 16; ++e) { const float pe = sc[jt][e] > -1.0e29f ? __expf(sc[jt][e] - mx) : 0.f; sc[jt][e] = pe; sum += pe; }
        }
        sum += __shfl_xor(sum, 32);
        f32x16 ot[2];
#pragma unroll
        for (int dt = 0; dt < 2; ++dt)
#pragma unroll
            for (int e = 0; e < 16; ++e) ot[dt][e] = 0.f;
#pragma unroll
        for (int jt = 0; jt < 5; ++jt)
#pragma unroll
            for (int s2 = 0; s2 < 2; ++s2) {
                u32x4 pb; pb.x = cvt_pk_bf16(sc[jt][8 * s2 + 0], sc[jt][8 * s2 + 1]); pb.y = cvt_pk_bf16(sc[jt][8 * s2 + 2], sc[jt][8 * s2 + 3]); pb.z = cvt_pk_bf16(sc[jt][8 * s2 + 4], sc[jt][8 * s2 + 5]); pb.w = cvt_pk_bf16(sc[jt][8 * s2 + 6], sc[jt][8 * s2 + 7]);
                const int kb = 32 * wid + 32 * jt + 16 * s2 + 4 * h2;
#pragma unroll
                for (int dt = 0; dt < 2; ++dt) {
                    ldsp vp = L + A_VT + ((32 * dt + n32) * A_VTP + kb) * 2;
                    const u32x2 lo = *(LAS const u32x2*)vp, hi = *(LAS const u32x2*)(vp + 16); u32x4 va; va.x = lo.x; va.y = lo.y; va.z = hi.x; va.w = hi.y;
                    ot[dt] = MFMA32(as_bf16x8(va), as_bf16x8(pb), ot[dt]);
                }
            }
        const float inv = 1.f / sum;
        bf16_t* orow = ao + qtok * 768 + head * 64;
#pragma unroll
        for (int dt = 0; dt < 2; ++dt)
#pragma unroll
            for (int g4 = 0; g4 < 4; ++g4) { u32x2 v; v.x = cvt_pk_bf16(ot[dt][4 * g4] * inv, ot[dt][4 * g4 + 1] * inv); v.y = cvt_pk_bf16(ot[dt][4 * g4 + 2] * inv, ot[dt][4 * g4 + 3] * inv);
                *(u32x2*)(orow + 32 * dt + 8 * g4 + 4 * h2) = v; }
        if (h2 == 0) lse[qtok * 12 + head] = mx + __logf(sum);
    }
}
__device__ __forceinline__ void attn_combine_phase(const int tid, const bf16_t* __restrict__ ao, const float* __restrict__ lse, bf16_t* __restrict__ dst) {
    constexpr int U = 4;
    const size_t S = (size_t)gridDim.x * NTHR, NE = (size_t)MTOK * 96;
    for (size_t e0 = (size_t)blockIdx.x * NTHR + tid; e0 < NE; e0 += S * U) {
        float l0[U], l1[U], l2[U], lh[U]; u32x4 a[U];
#pragma unroll
        for (int u = 0; u < U; ++u) { const size_t e = e0 + u * S < NE ? e0 + u * S : e0; const size_t t = e / 96; const int c8 = (int)(e % 96), head = c8 >> 3, i = head & 3;
            l0[u] = lse[t * 12 + i]; l1[u] = lse[t * 12 + 4 + i]; l2[u] = lse[t * 12 + 8 + i]; lh[u] = lse[t * 12 + head]; a[u] = *(const u32x4*)(ao + e * 8); }
#pragma unroll
        for (int u = 0; u < U; ++u) { const size_t e = e0 + u * S; if (e >= NE) break;
            const float m = fmaxf(l0[u], fmaxf(l1[u], l2[u])), al = __expf(lh[u] - m) / (__expf(l0[u] - m) + __expf(l1[u] - m) + __expf(l2[u] - m));
            u32x4 v; v.x = cvt_pk_bf16(bf_lo(a[u].x) * al, bf_hi(a[u].x) * al); v.y = cvt_pk_bf16(bf_lo(a[u].y) * al, bf_hi(a[u].y) * al); v.z = cvt_pk_bf16(bf_lo(a[u].z) * al, bf_hi(a[u].z) * al); v.w = cvt_pk_bf16(bf_lo(a[u].w) * al, bf_hi(a[u].w) * al);
            *(u32x4*)(dst + e * 8) = v; }
    }
}

#define XB_TMO      128
#define XB_XCNT(j)  (256  + 64 * (j))
#define XB_XSUB(j)  (1280 + 64 * (j))
#define XB_XGEN(j)  (2304 + 64 * (j))
#define XB_TOP      3328
#define XB_TOPGEN   3392
#define XCD_BAR_WORDS 3456
#define XB_SPIN_CAP (1u << 20)
__device__ __forceinline__ unsigned xb_ld(unsigned* p)              { return __hip_atomic_load(p, __ATOMIC_RELAXED, __HIP_MEMORY_SCOPE_AGENT); }
__device__ __forceinline__ unsigned xb_add(unsigned* p, unsigned v) { return __hip_atomic_fetch_add(p, v, __ATOMIC_RELAXED, __HIP_MEMORY_SCOPE_AGENT); }
__device__ __forceinline__ unsigned xb_xcc_id() { return (unsigned)__builtin_amdgcn_s_getreg((3 << 11) | 20) & 0xFu; }
#define XB_SPIN(cond, bar) do { unsigned _sp = 0; while (cond) { __builtin_amdgcn_s_sleep(1); \
    if ((++_sp & 255u) == 0u) { if (xb_ld(&(bar)[XB_TMO])) break; if (_sp > XB_SPIN_CAP) { atomicAdd(&(bar)[XB_TMO], 1u); break; } } } } while (0)
struct XcdBarrier { unsigned* bar; unsigned x; volatile LAS unsigned* st; };
__device__ __forceinline__ XcdBarrier xcd_barrier_post(unsigned* bar, volatile LAS unsigned* st) {
    XcdBarrier b; b.bar = bar; b.x = xb_xcc_id(); b.st = st;
    if (threadIdx.x == 0) (void)xb_add(&bar[XB_XCNT(b.x)], 1u);
    return b;
}
__device__ __forceinline__ void xcd_barrier_complete(unsigned* bar, unsigned x, unsigned& nloc, unsigned& nx) {
    const unsigned G = gridDim.x * gridDim.y * gridDim.z;
    unsigned sum, cnt, mine, sp = 0u;
    for (;;) {
        sum = 0u; cnt = 0u; mine = 0u;
#pragma unroll
        for (unsigned j = 0; j < 16; ++j) { const unsigned c = xb_ld(&bar[XB_XCNT(j)]); sum += c; cnt += (c > 0u) ? 1u : 0u; mine = (j == x) ? c : mine; }
        if (sum == G) break;
        __builtin_amdgcn_s_sleep(1);
        if ((++sp & 255u) == 0u) { if (xb_ld(&bar[XB_TMO])) break; if (sp > XB_SPIN_CAP) { atomicAdd(&bar[XB_TMO], 1u); break; } }
    }
    nloc = mine > 0u ? mine : 1u; nx = cnt > 0u ? cnt : 1u;
}
__device__ __forceinline__ void xcd_barrier(const XcdBarrier& b) {
    asm volatile("s_waitcnt vmcnt(0)" ::: "memory");
    __syncthreads();
    if (threadIdx.x == 0) {
        unsigned* bar = b.bar;
        __builtin_amdgcn_s_waitcnt(0);
        unsigned nloc = b.st[0], nx = b.st[1];
        if (nloc == 0u) { xcd_barrier_complete(bar, b.x, nloc, nx); b.st[0] = nloc; b.st[1] = nx; }
        const unsigned old = xb_add(&bar[XB_XSUB(b.x)], 1u);
        const unsigned gen = old / nloc;
        if (old + 1u == (gen + 1u) * nloc) {
            __builtin_amdgcn_fence(__ATOMIC_RELEASE, "agent");
            asm volatile("s_waitcnt vmcnt(0)" ::: "memory");
            const unsigned og = xb_add(&bar[XB_TOP], 1u);
            const unsigned tg = og / nx;
            if (og + 1u == (tg + 1u) * nx) xb_add(&bar[XB_TOPGEN], 1u);
            else XB_SPIN(xb_ld(&bar[XB_TOPGEN]) == tg, bar);
            __builtin_amdgcn_fence(__ATOMIC_ACQUIRE, "agent");
            xb_add(&bar[XB_XGEN(b.x)], 1u);
            asm volatile("s_waitcnt vmcnt(0)" ::: "memory");
        } else {
            XB_SPIN(xb_ld(&bar[XB_XGEN(b.x)]) == gen, bar);
            __builtin_amdgcn_fence(__ATOMIC_ACQUIRE, "agent");
            asm volatile("s_waitcnt vmcnt(0)" ::: "memory");
        }
    }
    __syncthreads();
}

struct EpiBf16Any {
    static constexpr bool PERM = true, AFTER_DRAIN = false;
    bf16_t* O; int ldc; int gdn; bf16_t* z; float* gates; bf16_t* halo;
    __device__ __forceinline__ void operator()(const f32x4 (&acc)[2][2][4][2], const Unit& u, int wr, int wc, int fr, int fq) const {
        const int row0 = u.pm * 256 + wr * 64 + fr;
        bf16_t* base = O; int ld = ldc, colt = u.pn * 256;
        if (gdn) {
            if (u.pn >= 16) {
                if (wc == 0) {
#pragma unroll
                    for (int ai = 0; ai < 2; ++ai)
#pragma unroll
                        for (int m = 0; m < 4; ++m) { float* g = gates + (size_t)(row0 + ai * 128 + m * 16) * 32 + 8 * fq; *(f32x4*)g = acc[ai][0][m][0]; *(f32x4*)(g + 4) = acc[ai][0][m][1]; }
                }
                return;
            }
            if (u.pn >= 12) { base = z; ld = 1024; colt = (u.pn - 12) * 256; }
        }
        const int col0 = colt + wc * 32 + 8 * fq;
#pragma unroll
        for (int ai = 0; ai < 2; ++ai)
#pragma unroll
            for (int m = 0; m < 4; ++m) { bf16_t* rowp = base + (size_t)(row0 + ai * 128 + m * 16) * ld + col0;
#pragma unroll
                for (int bj = 0; bj < 2; ++bj) { const f32x4 v0 = acc[ai][bj][m][0], v1 = acc[ai][bj][m][1]; u32x4 o; o.x = cvt_pk_bf16(v0[0], v0[1]); o.y = cvt_pk_bf16(v0[2], v0[3]); o.z = cvt_pk_bf16(v1[0], v1[1]); o.w = cvt_pk_bf16(v1[2], v1[3]);
                    *(u32x4*)(rowp + bj * 128) = o;
                    if (gdn && u.pn < 12 && ((m == 0 && fr < 2) || (m == 3 && fr >= 14))) {
                        const int r = row0 + ai * 128 + m * 16, rl = r & 63, hb = (r >> 6) + (rl >= 62 ? 1 : 0), hs = rl >= 62 ? rl - 62 : 2 + rl;
                        *(u32x4*)(halo + ((size_t)hb * 4 + hs) * 3072 + col0 + bj * 128) = o; } }
                asm volatile("" ::: "memory"); }
    }
};

__device__ __forceinline__ void prep_weights(const int tid, ldsp L, const Params& p, bf16_t* W, int wi_lo, int wi_hi, int tstart, int tstride) {
    for (int wi = wi_lo; wi < wi_hi; ++wi) {
        const float* src; bf16_t* dst; int K, N, Np;
        switch (wi) {
        case 0: src = p.in[5]; dst = W + W_GDN_IN; K = 1024; N = 4128; Np = 4352; break;
        case 1: src = p.in[10]; dst = W + W_GDN_OUT; K = 1024; N = 1024; Np = 1024; break;
        case 2: src = p.in[11]; dst = W + W_ATT_IN; K = 1024; N = 2304; Np = 2304; break;
        case 3: src = p.in[12]; dst = W + W_ATT_OUT; K = 768; N = 1024; Np = 1024; break;
        case 4: src = p.in[14]; dst = W + W_FFN_UP; K = 1024; N = 5632; Np = 5632; break;
        case 5: src = p.in[14] + (size_t)1024 * 5632; dst = W + W_FFN_UP + (size_t)5632 * 1024; K = 1024; N = 5632; Np = 5632; break;
        case 6: src = p.in[17]; dst = W + W_FFN_DOWN; K = 2816; N = 1024; Np = 1024; break;
        default: src = p.in[17] + (size_t)2816 * 1024; dst = W + W_FFN_DOWN + (size_t)1024 * 2816; K = 2816; N = 1024; Np = 1024; break;
        }
        wt_convert(tid, L, src, dst, K, N, Np, (wi == 4 || wi == 5) ? 1 : 0, tstart, tstride);
    }
}
enum { K_PREP = 0, K_RMS, K_GEMM_BF16, K_GEMM_RESID, K_GDNLOC, K_GDN, K_GDNCOMB, K_GEMM_UP, K_FIX, K_ATT, K_ATTCOMB, K_FINAL };
constexpr int NPHASE = 21;
__device__ __forceinline__ void decode_phase(int ph, int& kind, int& which, int& layer, bool& sync) {
    layer = 0; which = 0; sync = true;
    switch (ph) {
    case 0: kind = K_PREP; sync = false; break;
    case 1: kind = K_RMS; which = 0; break;
    case 2: kind = K_GEMM_BF16; which = 0; break;
    case 3: kind = K_GDNLOC; break;
    case 4: kind = K_GDN; break;
    case 5: kind = K_GDNCOMB; break;
    case 6: kind = K_GEMM_RESID; which = 0; break;
    case 7: kind = K_RMS; which = 1; break;
    case 8: kind = K_GEMM_UP; break;
    case 9: kind = K_FIX; break;
    case 10: kind = K_GEMM_RESID; which = 1; break;
    case 11: kind = K_RMS; which = 2; break;
    case 12: kind = K_GEMM_BF16; which = 2; break;
    case 13: kind = K_ATT; break;
    case 14: kind = K_ATTCOMB; break;
    case 15: kind = K_GEMM_RESID; which = 2; break;
    case 16: kind = K_RMS; which = 3; break;
    case 17: kind = K_GEMM_UP; layer = 1; break;
    case 18: kind = K_FIX; layer = 1; break;
    case 19: kind = K_GEMM_RESID; which = 1; layer = 1; break;
    default: kind = K_FINAL; sync = false; break;
    }
}

__global__ void __launch_bounds__(512, 2) mega_fwd(Params p) {
    extern __shared__ __attribute__((aligned(16))) unsigned char shm[];
    ldsp L = (ldsp)shm;
    cg::grid_group grid = cg::this_grid();
    __shared__ uint4 xb_words;
    if (threadIdx.x == 0) xb_words = make_uint4(0u, 0u, 0u, 0u);
    __syncthreads();
    const XcdBarrier xb = xcd_barrier_post((unsigned*)(p.ws + WS_BAR), (volatile LAS unsigned*)&xb_words);
#ifdef PROBE
    unsigned long long pr_acc[2] = {0ull, 0ull}; const unsigned long long pr_start = __builtin_amdgcn_s_memrealtime();
#endif
    for (int ph = 0; ph < NPHASE; ++ph) {
#ifdef PROBE
        const unsigned long long pr_t0 = __builtin_amdgcn_s_memrealtime();
#endif
        int tid; asm volatile("v_mov_b32 %0, %1" : "=v"(tid) : "v"((int)threadIdx.x));
        unsigned char* ws = p.ws;
        bf16_t* W = (bf16_t*)(ws + WS_W);
        bf16_t* R1 = (bf16_t*)(ws + WS_R1); bf16_t* R2 = (bf16_t*)(ws + WS_R2); bf16_t* R3 = (bf16_t*)(ws + WS_R3); float* R4 = (float*)(ws + WS_R4);
        bf16_t* hmid = R3; float* raw = (float*)(R3 + (size_t)MTOK * 2816);
        bf16_t* ao = R3 + (size_t)MTOK * 2304; bf16_t* XB = (bf16_t*)p.out + (size_t)MTOK * 1024;
        int kind, which, layer; bool sync;
        decode_phase(ph, kind, which, layer, sync);
        switch (kind) {
        case K_PREP:
            prep_weights(tid, L, p, W, 0, gridDim.x == 256 ? 2 : 8, (int)blockIdx.x, (int)gridDim.x); break;
        case K_RMS: {
            const float* w = which == 0 ? p.in[2] : (which == 1 ? p.in[3] : (which == 2 ? p.in[2] + 1024 : p.in[3] + 1024));
            if (which == 0) rmsnorm_f32in_phase(tid, p.in[0], p.in[1], TPROMPT, w, R1);
            else rmsnorm_bf16_phase(tid, which == 3 ? (const bf16_t*)R1 : (const bf16_t*)XB, w, which == 3 ? R2 : R1);
        } break;
        case K_GEMM_BF16: {
            EpiBf16Any E; E.gdn = 0; E.z = R2; E.gates = R4; E.halo = (bf16_t*)(ws + WS_HALO); const bf16_t* A; const bf16_t* Bt; int M, N;
            if (which == 0) { A = R1; Bt = W + W_GDN_IN; M = MTOK; N = 4352; E.O = R3; E.ldc = 3072; E.gdn = 1; }
            else { A = R1; Bt = W + W_ATT_IN; M = MTOK; N = 2304; E.O = R3; E.ldc = 2304; }
            run_gemm(tid, L, A, Bt, M, N, 1024, E);
        } break;
        case K_GEMM_RESID: {
            EpiResid E; E.outf = nullptr; E.ob = nullptr; E.r0 = p.in[0]; E.r1 = p.in[1]; E.split = TPROMPT; E.rb = nullptr; const bf16_t* A; const bf16_t* Bt; int M, K;
            if (which == 0) { A = R3; Bt = W + W_GDN_OUT; M = MTOK; K = 1024; E.ob = XB; }
            else if (which == 1) { A = hmid; Bt = W + W_FFN_DOWN + (size_t)layer * 1024 * 2816; M = MTOK; K = 2816;
                if (layer == 0) { E.rb = XB; E.ob = XB; }
                else { E.rb = R1; E.ob = R2; } }
            else { A = R2; Bt = W + W_ATT_OUT; M = MTOK; K = 768; E.rb = XB; E.ob = R1; }
            run_gemm(tid, L, A, Bt, M, 1024, K, E);
        } break;
        case K_GDNLOC: gdn_local_phase(tid, L, p, R3, (const bf16_t*)(ws + WS_HALO), R4, R1, (bf16_t*)p.out, (bf16_t*)p.out + (size_t)MTOK * 1024, (float*)(ws + WS_GSC)); break;
        case K_GDN: gdn_scan_phase(tid, L, R3, R1, (bf16_t*)p.out, (const bf16_t*)p.out + (size_t)MTOK * 1024, (const float*)(ws + WS_GSC), (bf16_t*)(ws + WS_OPF), (bf16_t*)(ws + WS_OPB));
            if (gridDim.x == 256 && blockIdx.x >= 128) { __syncthreads(); prep_weights(tid, L, p, W, 2, 8, (int)blockIdx.x - 128, 128); }
            break;
        case K_GDNCOMB: gdn_combine_phase(tid, L, p, R1, (const bf16_t*)p.out, R2, R3, (const bf16_t*)(ws + WS_OPF), (const bf16_t*)(ws + WS_OPB)); break;
        case K_GEMM_UP: {
            EpiFfnUp E; E.hmid = hmid; E.raw = raw; E.cw = p.in[15] + (size_t)layer * 3 * 5632; E.cb = p.in[16] + (size_t)layer * 5632; E.X = L + LDS_XCHG;
            run_gemm(tid, L, layer == 0 ? R1 : R2, W + W_FFN_UP + (size_t)layer * 5632 * 1024, MTOK, 5632, 1024, E);
        } break;
        case K_FIX: ffn_fix_phase(tid, raw, hmid, p.in[15] + (size_t)layer * 3 * 5632, p.in[16] + (size_t)layer * 5632); break;
#ifndef NO_ATT
        case K_ATT: attn_phase(tid, L, p, R3, ao, R4); break;
#endif
        case K_ATTCOMB: attn_combine_phase(tid, ao, R4, R2); break;
#ifdef PROBE
        default: rmsnorm_final_bf16_phase(tid, R2, p.in[4], p.out, *(volatile float*)(ws + WS_END)); break;
#else
        default: rmsnorm_final_bf16_phase(tid, R2, p.in[4], p.out, 0.f); break;
#endif
        }
#ifdef PROBE
        if (ph == NPHASE - 2 && blockIdx.x == 0 && threadIdx.x == 0) {
            const unsigned long long now = __builtin_amdgcn_s_memrealtime(); if (PROBE_A(kind)) pr_acc[0] += now - pr_t0; if (PROBE_B(kind)) pr_acc[1] += now - pr_t0;
            const float tot = (float)(now - pr_start); const float fa = fminf(rintf(100.f * (float)pr_acc[0] / tot), 99.f), fb = fminf(rintf(100.f * (float)pr_acc[1] / tot), 99.f);
            const float V = (fa + fb * 0.01f) * 0.01f; *(volatile float*)(ws + WS_END) = sqrtf(V * 1.0e-4f * 1.0004f);
            __threadfence();
        }
#endif
        if (sync) { if (ph == 1) grid.sync(); else xcd_barrier(xb); }
#ifdef PROBE
        if (ph < NPHASE - 2) { const unsigned long long now = __builtin_amdgcn_s_memrealtime(); if (PROBE_A(kind)) pr_acc[0] += now - pr_t0; if (PROBE_B(kind)) pr_acc[1] += now - pr_t0; }
#endif
    }
}

extern "C" void kernel_launch(void* const* d_in, const int* in_sizes, int n_in, void* d_out, int out_size, void* d_ws, size_t ws_size, hipStream_t stream) {
    static int grid_blocks = 0;
    if (grid_blocks == 0) {
        if (n_in != 18 || ws_size < WS_END) { fprintf(stderr, "kernel_launch: unexpected n_in %d / ws_size %zu\n", n_in, ws_size); grid_blocks = -1; return; }
        int dev = 0, cus = 0, per_cu = 0;
        hipGetDevice(&dev); hipDeviceGetAttribute(&cus, hipDeviceAttributeMultiprocessorCount, dev);
        if (hipFuncSetAttribute((const void*)mega_fwd, hipFuncAttributeMaxDynamicSharedMemorySize, LDS_BYTES) != hipSuccess) { fprintf(stderr, "kernel_launch: hipFuncSetAttribute failed\n"); grid_blocks = -1; return; }
        if (hipOccupancyMaxActiveBlocksPerMultiprocessor(&per_cu, (const void*)mega_fwd, NTHR, LDS_BYTES) != hipSuccess || per_cu < 1) { fprintf(stderr, "kernel_launch: occupancy query gave %d\n", per_cu); per_cu = 1; }
        (void)hipGetLastError();
        grid_blocks = cus;
    }
    if (grid_blocks < 0) return;
    Params p{};
    for (int i = 0; i < 18; ++i) p.in[i] = (const float*)d_in[i];
    p.out = (float*)d_out; p.ws = (unsigned char*)d_ws;
    if (hipMemsetAsync((unsigned char*)d_ws + WS_BAR, 0, 16384, stream) != hipSuccess) { fprintf(stderr, "kernel_launch: memset of the barrier words failed\n"); return; }
    void* args[] = {&p};
    hipError_t e = hipLaunchCooperativeKernel((const void*)mega_fwd, dim3(grid_blocks), dim3(NTHR), args, LDS_BYTES, stream);
    if (e != hipSuccess) fprintf(stderr, "cooperative launch failed: %s (grid %d)\n", hipGetErrorString(e), grid_blocks);
}
```
